# Optimizing an MI355X kernel written in HIP

```python
import math
import jax
import jax.numpy as jnp
from jax import lax
import numpy as np

D_MODEL = 4096
BATCH = 4
SEQ = 4096
DEPTH = 1


HEAD_DIM = 128
HGRN_DK = 128
HGRN_DV = 128
N_HGRN_HEADS = (D_MODEL // 2) // HGRN_DV
HGRN_F_DIM = N_HGRN_HEADS * HGRN_DK
HGRN_WIDTH = N_HGRN_HEADS * HGRN_DV
N_MOBA_HEADS = (D_MODEL // 2) // HEAD_DIM
MOBA_WIDTH = N_MOBA_HEADS * HEAD_DIM
D_MIX = HGRN_WIDTH + MOBA_WIDTH
D_IN_PROJ = 2 * HGRN_F_DIM + 2 * HGRN_WIDTH + 3 * MOBA_WIDTH
D_FF = ((8 * D_MODEL // 3 + 255) // 256) * 256
MOBA_BLOCK = 256
MOBA_TOPK = 3
HGRN_CHUNK = 64
Q_CHUNK = 16
MACARON_WEIGHT = 0.5
RMS_EPS = 1e-6

kernel_name = 'hybrid_hgrn2_moba_macaron_layer'


def rmsnorm(x, g):
    xf = x.astype(jnp.float32)
    r = lax.rsqrt(jnp.mean(xf * xf, axis=-1, keepdims=True) + RMS_EPS)
    return (xf * r).astype(x.dtype) * g


def swiglu(h, w_gate, w_up, w_down):
    return (jax.nn.silu(h @ w_gate) * (h @ w_up)) @ w_down


def _heads(a, n_heads):
    b_, s_, w_ = a.shape
    return a.reshape(b_, s_, n_heads, w_ // n_heads).transpose(0, 2, 1, 3)


def _merge(a):
    b_, h_, s_, d_ = a.shape
    return a.transpose(0, 2, 1, 3).reshape(b_, s_, h_ * d_)


def hgrn2_chunkwise(q, k, v, log_f):
    b_, h_, s_, dk = q.shape
    dv = v.shape[-1]
    n_chunks = s_ // HGRN_CHUNK

    def to_chunks(a):
        return jnp.moveaxis(a.reshape(b_, h_, n_chunks, HGRN_CHUNK, a.shape[-1]), 2, 0)

    causal = jnp.tril(jnp.ones((HGRN_CHUNK, HGRN_CHUNK), dtype=bool))

    def step(state, inp):
        qc, kc, vc, gc = inp
        cum = jnp.cumsum(gc, axis=2)
        o_inter = jnp.einsum('bhtk,bhkv->bhtv', qc * jnp.exp(cum), state)
        rel = cum[:, :, :, None, :] - cum[:, :, None, :, :]
        decay = jnp.exp(jnp.where(causal[:, :, None], rel, -jnp.inf))
        scores = jnp.einsum('bhtk,bhsk,bhtsk->bhts', qc, kc, decay)
        o_intra = jnp.einsum('bhts,bhsv->bhtv', scores, vc)
        last = cum[:, :, -1, :]
        k_to_end = kc * jnp.exp(last[:, :, None, :] - cum)
        new_state = jnp.exp(last)[..., None] * state + jnp.einsum('bhsk,bhsv->bhkv', k_to_end, vc)
        return new_state, o_inter + o_intra

    state0 = jnp.zeros((b_, h_, dk, dv), jnp.float32)
    _, o = lax.scan(step, state0, (to_chunks(q), to_chunks(k), to_chunks(v), to_chunks(log_f)))
    return jnp.moveaxis(o, 0, 2).reshape(b_, h_, s_, dv)


def hgrn2_mixer(hq, hf, hi, hg, lower_bound, norm_gain):
    f32 = jnp.float32
    forget = lower_bound + (1.0 - lower_bound) * jax.nn.sigmoid(hf.astype(f32))
    q = _heads(jax.nn.silu(hq.astype(f32)) * HGRN_DK ** -0.5, N_HGRN_HEADS)
    k = _heads(1.0 - forget, N_HGRN_HEADS)
    log_f = _heads(jnp.log(forget), N_HGRN_HEADS)
    v = _heads(hi.astype(f32), N_HGRN_HEADS)
    o = hgrn2_chunkwise(q, k, v, log_f)
    o = rmsnorm(o, norm_gain)
    o = _merge(o) * jax.nn.silu(hg.astype(f32))
    return o.astype(hq.dtype)


def moba_attention(q, k, v):
    f32 = jnp.float32
    b_, h_, s_, d_ = q.shape
    L = MOBA_BLOCK
    nb = -(-s_ // L)
    s_pad = nb * L
    topk = min(MOBA_TOPK, max(nb - 1, 1))
    scale = d_ ** -0.5
    slopes = jnp.exp2(-8.0 * jnp.arange(1, h_ + 1, dtype=f32) / h_)
    pad = ((0, 0), (0, 0), (0, s_pad - s_), (0, 0))
    kb = jnp.pad(k, pad).reshape(b_, h_, nb, L, d_)
    vb = jnp.pad(v, pad).reshape(b_, h_, nb, L, d_)
    k_mean = jnp.mean(kb.astype(f32), axis=3)
    gate = jnp.einsum('bhtd,bhnd->bhtn', q.astype(f32), k_mean)
    q_block = jnp.arange(s_) // L
    past = jnp.arange(nb)[None, :] < q_block[:, None]
    gate = jnp.where(past, gate, -jnp.inf)
    _, sel = lax.top_k(gate, topk)

    n_qc = s_ // Q_CHUNK
    qc_all = jnp.moveaxis(q.reshape(b_, h_, n_qc, Q_CHUNK, d_), 2, 0)
    sel_all = jnp.moveaxis(sel.reshape(b_, h_, n_qc, Q_CHUNK, topk), 2, 0)
    bi = jnp.arange(b_)[:, None, None, None]
    hi = jnp.arange(h_)[None, :, None, None]
    offs = jnp.arange(L)

    def one_chunk(args):
        c, qi, si = args
        t = c * Q_CHUNK + jnp.arange(Q_CHUNK)
        own = (c * Q_CHUNK) // L
        k_own = lax.dynamic_index_in_dim(kb, own, axis=2, keepdims=False)
        v_own = lax.dynamic_index_in_dim(vb, own, axis=2, keepdims=False)
        k_sel = kb[bi, hi, si]
        v_sel = vb[bi, hi, si]
        s_sel = si[..., None] * L + offs
        sc_sel = (jnp.einsum('bhtd,bhtnld->bhtnl', qi, k_sel).astype(f32) * scale
                  - slopes[:, None, None, None] * (t[:, None, None] - s_sel).astype(f32))
        valid = jnp.arange(topk)[None, :] < (t // L)[:, None]
        sc_sel = jnp.where(valid[:, :, None], sc_sel, -jnp.inf)
        s_own = own * L + offs
        sc_own = (jnp.einsum('bhtd,bhsd->bhts', qi, k_own).astype(f32) * scale
                  - slopes[:, None, None] * (t[:, None] - s_own[None, :]).astype(f32))
        sc_own = jnp.where(s_own[None, :] <= t[:, None], sc_own, -jnp.inf)
        scores = jnp.concatenate([sc_sel.reshape(b_, h_, Q_CHUNK, topk * L), sc_own], axis=-1)
        p = jax.nn.softmax(scores, axis=-1)
        p_sel = p[..., :topk * L].reshape(b_, h_, Q_CHUNK, topk, L)
        p_own = p[..., topk * L:]
        o = (jnp.einsum('bhtnl,bhtnld->bhtd', p_sel, v_sel.astype(f32))
             + jnp.einsum('bhts,bhsd->bhtd', p_own, v_own.astype(f32)))
        return o.astype(q.dtype)

    o = lax.map(one_chunk, (jnp.arange(n_qc), qc_all, sel_all))
    return jnp.moveaxis(o, 0, 2).reshape(b_, h_, s_, d_)


def hybrid_mixer(h, w_in, lower_bound, hgrn_norm_gain, w_out):
    proj = h @ w_in
    cuts = np.cumsum([HGRN_F_DIM, HGRN_F_DIM, HGRN_WIDTH, HGRN_WIDTH,
                      MOBA_WIDTH, MOBA_WIDTH]).tolist()
    hq, hf, hi, hg, mq, mk, mv = jnp.split(proj, cuts, axis=-1)
    o_hgrn = hgrn2_mixer(hq, hf, hi, hg, lower_bound, hgrn_norm_gain)
    o_moba = _merge(moba_attention(_heads(mq, N_MOBA_HEADS), _heads(mk, N_MOBA_HEADS),
                                   _heads(mv, N_MOBA_HEADS)))
    return jnp.concatenate([o_hgrn, o_moba], axis=-1) @ w_out


def setup_inputs(seed: int = 0) -> dict:
    key = jax.random.key(seed)
    ks = jax.random.split(key, 16)
    f32 = jnp.float32

    def dense(k, shape):
        return jax.random.normal(k, shape, f32) * shape[-2] ** -0.5

    def gain(k, shape):
        return 1.0 + 0.02 * jax.random.normal(k, shape, f32)

    return {
        'x': jax.random.normal(ks[0], (BATCH, SEQ, D_MODEL), f32),
        'ffn1_norm': gain(ks[1], (DEPTH, D_MODEL)),
        'ffn1_w_gate': dense(ks[2], (DEPTH, D_MODEL, D_FF)),
        'ffn1_w_up': dense(ks[3], (DEPTH, D_MODEL, D_FF)),
        'ffn1_w_down': dense(ks[4], (DEPTH, D_FF, D_MODEL)),
        'mix_norm': gain(ks[5], (DEPTH, D_MODEL)),
        'w_in': dense(ks[6], (DEPTH, D_MODEL, D_IN_PROJ)),
        'hgrn_lower_bounds': 0.1 * jax.random.normal(ks[7], (DEPTH + 1, HGRN_F_DIM), f32),
        'hgrn_out_norm': gain(ks[8], (DEPTH, HGRN_DV)),
        'w_out': dense(ks[9], (DEPTH, D_MIX, D_MODEL)),
        'ffn2_norm': gain(ks[10], (DEPTH, D_MODEL)),
        'ffn2_w_gate': dense(ks[11], (DEPTH, D_MODEL, D_FF)),
        'ffn2_w_up': dense(ks[12], (DEPTH, D_MODEL, D_FF)),
        'ffn2_w_down': dense(ks[13], (DEPTH, D_FF, D_MODEL)),
        'final_norm': gain(ks[14], (D_MODEL,)),
    }


def reference(x, ffn1_norm, ffn1_w_gate, ffn1_w_up, ffn1_w_down, mix_norm, w_in,
              hgrn_lower_bounds, hgrn_out_norm, w_out, ffn2_norm, ffn2_w_gate,
              ffn2_w_up, ffn2_w_down, final_norm):
    lb_all = jnp.cumsum(jax.nn.softmax(hgrn_lower_bounds.astype(jnp.float32), axis=0), axis=0)
    for layer in range(DEPTH):
        h = rmsnorm(x, ffn1_norm[layer])
        x = x + MACARON_WEIGHT * swiglu(h, ffn1_w_gate[layer], ffn1_w_up[layer], ffn1_w_down[layer])
        h = rmsnorm(x, mix_norm[layer])
        x = x + hybrid_mixer(h, w_in[layer], lb_all[layer], hgrn_out_norm[layer], w_out[layer])
        h = rmsnorm(x, ffn2_norm[layer])
        x = x + MACARON_WEIGHT * swiglu(h, ffn2_w_gate[layer], ffn2_w_up[layer], ffn2_w_down[layer])
    return rmsnorm(x, final_norm)
```

```cpp
#include <hip/hip_runtime.h>
#include <cstdio>
#include <cstdint>
namespace pg8 {
#define PG8_LAS __attribute__((address_space(3)))
typedef unsigned short bf16_t;
typedef short bf16x8 __attribute__((ext_vector_type(8)));
typedef float f32x4 __attribute__((ext_vector_type(4)));
typedef unsigned u32x4 __attribute__((ext_vector_type(4)));
constexpr int BM = 256, BK = 64, HALF = 128, HTB = HALF * BK * 2  , STAGE_BYTES = 8 * HTB, NXCD = 8, WGM = 8;

__host__ __device__ __forceinline__ int lds_byte(int r, int c) { const int st = (r >> 4) * 2 + (c >> 5), rr = r & 15, cc = c & 31, ob = rr * 64 + cc * 2; return st * 1024 + (ob ^ (((ob >> 9) & 1) << 5)); }
__host__ __device__ __forceinline__ void stage_rc(int b, int& R, int& C) { const int st = b / 1024, sb = b % 1024, swz = sb ^ (((sb >> 9) & 1) << 5); R = (st >> 1) * 16 + swz / 64; C = (st & 1) * 32 + (swz % 64) / 2; }
__host__ __device__ __forceinline__ int perm32(int rho) { const int n = rho >> 4, i = rho & 15; return 8 * (i >> 2) + 4 * n + (i & 3); }

struct Unit { int pm, pn; };
struct Gemm { const bf16_t* A; const bf16_t* Bt; int M, N, K; };

struct StaticOrder {
    int nM, nN, nwg, G, c;
    __host__ __device__ void init(int M, int N, int G_, int c_) { nM = M / BM; nN = N / BM; nwg = nM * nN; G = G_; c = c_; }
    __host__ __device__ bool next(int i, Unit& u) const {
        const long L = (long)i * G + c; if (L >= nwg) return false;
        int wgid = (int)L; { const int q = nwg / NXCD, r = nwg % NXCD, xcd = wgid % NXCD, off = wgid / NXCD; wgid = (xcd < r ? xcd * (q + 1) : r * (q + 1) + (xcd - r) * q) + off; }
        const int nig = WGM * nN, gid = wgid / nig, fm = gid * WGM, gsz = (nM - fm) < WGM ? (nM - fm) : WGM;
        u.pm = fm + ((wgid % nig) % gsz); u.pn = (wgid % nig) / gsz; return true;
    }
    __device__ __forceinline__ void a_ready(const Unit&) const {}
    __device__ __forceinline__ void done(const Unit&) const {}
};

__device__ __forceinline__ unsigned cvt_pk_bf16(float lo, float hi) { unsigned r; asm volatile("v_cvt_pk_bf16_f32 %0, %1, %2" : "=v"(r) : "v"(lo), "v"(hi)); return r; }
typedef float f32x2 __attribute__((ext_vector_type(2)));

__device__ __forceinline__ float sigmoid_fast(float a) { return __builtin_amdgcn_rcpf(1.0f + __builtin_amdgcn_exp2f(-1.4426950408889634f * a)); }

struct EpiSwiGLU {
    static constexpr bool PERM = true, AFTER_DRAIN = false;
    bf16_t* O; int ldc;
    __device__ __forceinline__ void operator()(const f32x4 (&acc)[2][2][4][2], const Unit& u, int wr, int wc, int fr, int fq) const {
        const int row0 = u.pm * BM + wr * 64 + fr, col0 = u.pn * HALF + wc * 32 + 8 * fq;
#pragma unroll
        for (int ai = 0; ai < 2; ++ai)
#pragma unroll
            for (int m = 0; m < 4; ++m) { bf16_t* rowp = O + (size_t)(row0 + ai * HALF + m * 16) * ldc + col0;
                f32x4 v0, v1;
#pragma unroll
                for (int i = 0; i < 4; ++i) { const float g0 = acc[ai][0][m][0][i], g1 = acc[ai][0][m][1][i];
                    v0[i] = g0 * sigmoid_fast(g0) * acc[ai][1][m][0][i]; v1[i] = g1 * sigmoid_fast(g1) * acc[ai][1][m][1][i]; }
                u32x4 w; w.x = cvt_pk_bf16(v0[0], v0[1]); w.y = cvt_pk_bf16(v0[2], v0[3]); w.z = cvt_pk_bf16(v1[0], v1[1]); w.w = cvt_pk_bf16(v1[2], v1[3]);
                *(u32x4*)rowp = w; }
    }
};

struct EpiResF32 {
    static constexpr bool PERM = false, AFTER_DRAIN = false;
    const float* base; float* out; int ldc; float alpha;
    __device__ __forceinline__ void operator()(const f32x4 (&acc)[2][2][4][2], const Unit& u, int wr, int wc, int fr, int fq) const {
        const int row0 = u.pm * BM + wr * 64 + fr, col0 = u.pn * BM + wc * 32 + 4 * fq;
#pragma unroll
        for (int ai = 0; ai < 2; ++ai)
#pragma unroll
            for (int m = 0; m < 4; ++m) { const size_t off = (size_t)(row0 + ai * HALF + m * 16) * ldc + col0;
                f32x4 bs[2][2];
#pragma unroll
                for (int bj = 0; bj < 2; ++bj)
#pragma unroll
                    for (int n = 0; n < 2; ++n) bs[bj][n] = *(const f32x4*)(base + off + bj * HALF + n * 16);
#pragma unroll
                for (int bj = 0; bj < 2; ++bj)
#pragma unroll
                    for (int n = 0; n < 2; ++n) *(f32x4*)(out + off + bj * HALF + n * 16) = bs[bj][n] + acc[ai][bj][m][n] * alpha;
                asm volatile("" ::: "memory"); }
    }
};

struct EpiInProj {
    static constexpr bool PERM = true, AFTER_DRAIN = false;
    bf16_t* QH; bf16_t* VH; bf16_t* GH; bf16_t* MQ; bf16_t* MK; bf16_t* MV; float* F; const float* lbnd;
    __device__ __forceinline__ void operator()(const f32x4 (&acc)[2][2][4][2], const Unit& u, int wr, int wc, int fr, int fq) const {
        const int seg = u.pn >> 3, cs = (u.pn & 7) * BM + wc * 32 + 8 * fq, row0 = u.pm * BM + wr * 64 + fr;
        if (seg == 1) {
            float lb[2][8];
#pragma unroll
            for (int bj = 0; bj < 2; ++bj)
#pragma unroll
                for (int n = 0; n < 2; ++n) { const f32x4 a = *(const f32x4*)(lbnd + cs + bj * HALF + 4 * n), b = *(const f32x4*)(lbnd + 2048 + cs + bj * HALF + 4 * n);
#pragma unroll
                    for (int i = 0; i < 4; ++i) lb[bj][4 * n + i] = sigmoid_fast(a[i] - b[i]); }
#pragma unroll
            for (int ai = 0; ai < 2; ++ai)
#pragma unroll
                for (int m = 0; m < 4; ++m) { float* rowp = F + (size_t)(row0 + ai * HALF + m * 16) * 2048 + cs;
#pragma unroll
                    for (int bj = 0; bj < 2; ++bj)
#pragma unroll
                        for (int n = 0; n < 2; ++n) { f32x4 o;
#pragma unroll
                            for (int i = 0; i < 4; ++i) { const float l = lb[bj][4 * n + i]; o[i] = l + (1.0f - l) * sigmoid_fast(acc[ai][bj][m][n][i]); }
                            *(f32x4*)(rowp + bj * HALF + 4 * n) = o; } }
        } else {
            bf16_t* base = QH; float sc = 0.08838834764831845f; bool act = true;
            if (seg == 2) { base = VH; sc = 1.f; act = false; }
            else if (seg == 3) { base = GH; sc = 1.f; act = true; }
            else if (seg == 4) { base = MQ; sc = 0.08838834764831845f * 1.4426950408889634f; act = false; }
            else if (seg == 5) { base = MK; sc = 1.f; act = false; }
            else if (seg == 6) { base = MV; sc = 1.f; act = false; }
#pragma unroll
            for (int ai = 0; ai < 2; ++ai)
#pragma unroll
                for (int m = 0; m < 4; ++m) { bf16_t* rowp = base + (size_t)(row0 + ai * HALF + m * 16) * 2048 + cs;
#pragma unroll
                    for (int bj = 0; bj < 2; ++bj) { f32x4 v0 = acc[ai][bj][m][0], v1 = acc[ai][bj][m][1];
                        if (act) {
#pragma unroll
                            for (int i = 0; i < 4; ++i) { v0[i] = v0[i] * sigmoid_fast(v0[i]); v1[i] = v1[i] * sigmoid_fast(v1[i]); } }
                        v0 = v0 * sc; v1 = v1 * sc;
                        u32x4 w; w.x = cvt_pk_bf16(v0[0], v0[1]); w.y = cvt_pk_bf16(v0[2], v0[3]); w.z = cvt_pk_bf16(v1[0], v1[1]); w.w = cvt_pk_bf16(v1[2], v1[3]);
                        *(u32x4*)(rowp + bj * HALF) = w; } }
        }
    }
};

template <class Epi, class Sched, bool ALIGN_EPI = false, bool SP2 = false>
__device__ __forceinline__ void gemm_phase(PG8_LAS unsigned char* lds, const Gemm g, const Sched& S, const Epi& E) {
    const int tid = threadIdx.x, wid = __builtin_amdgcn_readfirstlane(tid >> 6), lane = tid & 63, wr = wid >> 2, wc = wid & 3, fr = lane & 15, fq = lane >> 4;
    const int K = g.K, nt = K / BK;
    unsigned voffA[2], voffB[2];
#pragma unroll
    for (int i = 0; i < 2; ++i) { int R, C; stage_rc(tid * 16 + i * 8192, R, C); const int Rb = Epi::PERM ? ((R & ~31) + perm32(R & 31)) : R;
        voffA[i] = (unsigned)(R * K + C) * 2u; voffB[i] = (unsigned)(Rb * K + C) * 2u; }
    const size_t kstep = (size_t)(BK * 2);
    const size_t hstep = (size_t)HALF * K * 2;
    const size_t tstep = 2 * hstep;
    const unsigned ldsw = (unsigned)wid * 1024u;
    const int aoff = lds_byte(wr * 64 + fr, fq * 8), boff = lds_byte(wc * 32 + fr, fq * 8);
#define PG8_SA(b, h) (((b) * 2 + (h)) * HTB)
#define PG8_SB(b, h) ((4 + (b) * 2 + (h)) * HTB)
#define PG8_STAGE(bufoff, gbase, voff) do { _Pragma("unroll") for (int _i = 0; _i < 2; ++_i) \
        __builtin_amdgcn_global_load_lds((const unsigned*)((const char*)(gbase) + (voff)[_i]), (PG8_LAS unsigned*)(lds + (bufoff) + ldsw + _i * 8192), 16, 0, 0); } while (0)
#define PG8_LDA(dst, b, h) do { _Pragma("unroll") for (int m = 0; m < 4; ++m) _Pragma("unroll") for (int k = 0; k < 2; ++k) dst[m][k] = *(const PG8_LAS bf16x8*)(lds + PG8_SA(b, h) + aoff + m * 2048 + k * 1024); } while (0)
#define PG8_LDB(dst, b, h) do { _Pragma("unroll") for (int n = 0; n < 2; ++n) _Pragma("unroll") for (int k = 0; k < 2; ++k) dst[n][k] = *(const PG8_LAS bf16x8*)(lds + PG8_SB(b, h) + boff + n * 2048 + k * 1024); } while (0)
#define PG8_MMA(ai, bj, At, Bt) do { __builtin_amdgcn_s_setprio(1); _Pragma("unroll") for (int m = 0; m < 4; ++m) _Pragma("unroll") for (int n = 0; n < 2; ++n) _Pragma("unroll") for (int k = 0; k < 2; ++k) \
        acc[ai][bj][m][n] = __builtin_amdgcn_mfma_f32_16x16x32_bf16(Bt[n][k], At[m][k], acc[ai][bj][m][n], 0, 0, 0); __builtin_amdgcn_s_setprio(0); } while (0)
#define PG8_WAIT_V(n) asm volatile("s_waitcnt vmcnt(" #n ")" ::: "memory")
#define PG8_WAIT_L(n) asm volatile("s_waitcnt lgkmcnt(" #n ")" ::: "memory")
#define PG8_BAR __builtin_amdgcn_s_barrier()
#define PG8_SCHED __builtin_amdgcn_sched_barrier(0)
    Unit cur, nxt; int ui = 0;
    if (!S.next(0, cur)) return;
    f32x4 acc[2][2][4][2];
#pragma unroll
    for (int a = 0; a < 2; ++a)
#pragma unroll
        for (int b = 0; b < 2; ++b)
#pragma unroll
            for (int m = 0; m < 4; ++m)
#pragma unroll
                for (int n = 0; n < 2; ++n) acc[a][b][m][n] = (f32x4){0.f, 0.f, 0.f, 0.f};
    bf16x8 At[4][2], B0[2][2], B1[2][2];
    const char* cA = (const char*)g.A + (size_t)cur.pm * tstep; const char* cB = (const char*)g.Bt + (size_t)cur.pn * tstep;
    S.a_ready(cur);
    if constexpr (SP2) {
        PG8_STAGE(PG8_SB(0, 0), cB, voffB); PG8_STAGE(PG8_SB(0, 1), cB + hstep, voffB); PG8_STAGE(PG8_SA(0, 0), cA, voffA); PG8_STAGE(PG8_SA(0, 1), cA + hstep, voffA);
        if (wr == 1) PG8_BAR;
        PG8_WAIT_V(2); PG8_BAR;
        PG8_STAGE(PG8_SB(1, 0), cB + kstep, voffB); PG8_STAGE(PG8_SA(1, 0), cA + kstep, voffA); PG8_STAGE(PG8_SB(1, 1), cB + hstep + kstep, voffB);
        PG8_WAIT_V(6); PG8_BAR;
    } else {
        PG8_STAGE(PG8_SB(0, 0), cB, voffB); PG8_STAGE(PG8_SA(0, 0), cA, voffA); PG8_STAGE(PG8_SB(0, 1), cB + hstep, voffB); PG8_STAGE(PG8_SA(0, 1), cA + hstep, voffA);
        if (wr == 1) PG8_BAR;
        PG8_WAIT_V(4); PG8_BAR;
        PG8_STAGE(PG8_SB(1, 0), cB + kstep, voffB); PG8_STAGE(PG8_SA(1, 0), cA + kstep, voffA); PG8_STAGE(PG8_SB(1, 1), cB + hstep + kstep, voffB);
        PG8_WAIT_V(6); PG8_BAR;
    }
    for (;;) {
        const bool has_next = S.next(ui + 1, nxt);
        const char* nA = has_next ? (const char*)g.A + (size_t)nxt.pm * tstep : cA; const char* nB = has_next ? (const char*)g.Bt + (size_t)nxt.pn * tstep : cB;
        for (int t = 0; t < nt; t += 2) {
            const bool last = (t == nt - 2);
            const char* a1 = cA + (size_t)(t + 1) * kstep;
            const char* a2 = last ? nA : cA + (size_t)(t + 2) * kstep; const char* b2 = last ? nB : cB + (size_t)(t + 2) * kstep;
            const char* a3 = a2 + kstep; const char* b3 = b2 + kstep;
            if (last && has_next) S.a_ready(nxt);
            if constexpr (SP2) {
            PG8_LDB(B0, 0, 0); PG8_LDB(B1, 0, 1); PG8_SCHED; PG8_LDA(At, 0, 0); PG8_STAGE(PG8_SA(1, 1), a1 + hstep, voffA);
            PG8_WAIT_V(8); PG8_WAIT_L(0); PG8_BAR; PG8_MMA(0, 0, At, B0); PG8_MMA(0, 1, At, B1); PG8_BAR; PG8_SCHED;
            PG8_LDA(At, 0, 1); PG8_STAGE(PG8_SB(0, 0), b2, voffB); PG8_STAGE(PG8_SB(0, 1), b2 + hstep, voffB); PG8_STAGE(PG8_SA(0, 0), a2, voffA);
            PG8_WAIT_V(8); PG8_WAIT_L(0); PG8_BAR; PG8_MMA(1, 0, At, B0); PG8_MMA(1, 1, At, B1); PG8_BAR; PG8_SCHED;
            PG8_LDB(B0, 1, 0); PG8_LDB(B1, 1, 1); PG8_SCHED; PG8_LDA(At, 1, 0); PG8_STAGE(PG8_SA(0, 1), a2 + hstep, voffA);
            PG8_WAIT_V(8); PG8_WAIT_L(0); PG8_BAR; PG8_MMA(0, 0, At, B0); PG8_MMA(0, 1, At, B1); PG8_BAR; PG8_SCHED;
            PG8_LDA(At, 1, 1); PG8_STAGE(PG8_SB(1, 0), b3, voffB); PG8_STAGE(PG8_SB(1, 1), b3 + hstep, voffB); PG8_STAGE(PG8_SA(1, 0), a3, voffA);
            PG8_WAIT_V(8); PG8_WAIT_L(0); PG8_BAR; PG8_MMA(1, 0, At, B0); PG8_MMA(1, 1, At, B1); PG8_BAR; PG8_SCHED;
            } else {
            PG8_LDB(B0, 0, 0); PG8_SCHED; PG8_LDA(At, 0, 0); PG8_STAGE(PG8_SA(1, 1), a1 + hstep, voffA);
            PG8_WAIT_L(8); PG8_BAR; PG8_WAIT_L(0); PG8_MMA(0, 0, At, B0); PG8_BAR; PG8_SCHED;
            PG8_LDB(B1, 0, 1); PG8_STAGE(PG8_SB(0, 0), b2, voffB);
            PG8_BAR; PG8_WAIT_L(0); PG8_MMA(0, 1, At, B1); PG8_BAR;
            PG8_LDA(At, 0, 1); PG8_STAGE(PG8_SA(0, 0), a2, voffA);
            PG8_BAR; PG8_WAIT_L(0); PG8_MMA(1, 0, At, B0); PG8_BAR; PG8_SCHED;
            PG8_STAGE(PG8_SB(0, 1), b2 + hstep, voffB);
            PG8_WAIT_V(6); PG8_BAR; PG8_MMA(1, 1, At, B1); PG8_BAR;
            PG8_LDB(B0, 1, 0); PG8_SCHED; PG8_LDA(At, 1, 0); PG8_STAGE(PG8_SA(0, 1), a2 + hstep, voffA);
            PG8_WAIT_L(8); PG8_BAR; PG8_WAIT_L(0); PG8_MMA(0, 0, At, B0); PG8_BAR; PG8_SCHED;
            PG8_LDB(B1, 1, 1); PG8_STAGE(PG8_SB(1, 0), b3, voffB);
            PG8_BAR; PG8_WAIT_L(0); PG8_MMA(0, 1, At, B1); PG8_BAR;
            PG8_LDA(At, 1, 1); PG8_STAGE(PG8_SA(1, 0), a3, voffA);
            PG8_BAR; PG8_WAIT_L(0); PG8_MMA(1, 0, At, B0); PG8_BAR; PG8_SCHED;
            PG8_STAGE(PG8_SB(1, 1), b3 + hstep, voffB);
            PG8_WAIT_V(6); PG8_BAR; PG8_MMA(1, 1, At, B1); PG8_BAR;
            }
        }
        if constexpr (ALIGN_EPI) { if (wr == 0) PG8_BAR; }
        if constexpr (!Epi::AFTER_DRAIN) { E(acc, cur, wr, wc, fr, fq); S.done(cur); }
        if (!has_next) break;
#pragma unroll
        for (int a = 0; a < 2; ++a)
#pragma unroll
            for (int b = 0; b < 2; ++b)
#pragma unroll
                for (int m = 0; m < 4; ++m)
#pragma unroll
                    for (int n = 0; n < 2; ++n) acc[a][b][m][n] = (f32x4){0.f, 0.f, 0.f, 0.f};
        cur = nxt; cA = nA; cB = nB; ++ui;
        if constexpr (ALIGN_EPI) { if (wr == 1) PG8_BAR; }
    }
    PG8_WAIT_V(0);
    if constexpr (!ALIGN_EPI) { if (wr == 0) PG8_BAR; }
    PG8_BAR;
    if constexpr (Epi::AFTER_DRAIN) { E.fused(acc, cur, wr, wc, fr, fq, lds, wid, lane); S.done(cur); }
#undef PG8_SA
#undef PG8_SB
#undef PG8_STAGE
#undef PG8_LDA
#undef PG8_LDB
#undef PG8_MMA
#undef PG8_WAIT_V
#undef PG8_WAIT_L
#undef PG8_BAR
#undef PG8_SCHED
}
}

constexpr int NWAVES = 8;
#ifndef MK_N_LAUNCHES
#define MK_N_LAUNCHES 1
#endif
constexpr int PER_PHASE = 12;
constexpr int N_LAUNCHES = MK_N_LAUNCHES;

constexpr int BATCH = 4, SEQ = 4096, D = 4096, FF = 11008, NGU = 2 * FF, NIN = 14336, HW = 2048, NHEAD = 16, HD = 128;
constexpr int M = BATCH * SEQ;
constexpr float RMS_EPS = 1e-6f;

constexpr size_t MiB = 1u << 20;
constexpr size_t WS_CTL = 0, CTL_ZERO_BYTES = 1 * MiB;
constexpr size_t WS_KMEAN = 1 * MiB;
constexpr size_t WS_WGU1 = 2 * MiB, WS_WD1 = 174 * MiB, WS_WIN = 260 * MiB, WS_WOUT = 372 * MiB, WS_WGU2 = 404 * MiB, WS_WD2 = 576 * MiB;
constexpr size_t WS_XN = 662 * MiB;
constexpr size_t WS_ACT = 790 * MiB;
constexpr size_t WS_QH = WS_ACT, WS_VH = WS_ACT + 64 * MiB, WS_GH = WS_ACT + 128 * MiB, WS_MQ = WS_ACT + 192 * MiB, WS_MK = WS_ACT + 256 * MiB, WS_MV = WS_ACT + 320 * MiB;
constexpr size_t WS_F = 1238 * MiB;
constexpr size_t WS_ORAW = 1366 * MiB;
constexpr size_t WS_END = 1494 * MiB;
static_assert(WS_WGU1 + (size_t)NGU * D * 2 <= WS_WD1 && WS_WD1 + (size_t)D * FF * 2 <= WS_WIN && WS_WIN + (size_t)NIN * D * 2 <= WS_WOUT && WS_WOUT + (size_t)D * D * 2 <= WS_WGU2 &&
              WS_WGU2 + (size_t)NGU * D * 2 <= WS_WD2 && WS_WD2 + (size_t)D * FF * 2 <= WS_XN && WS_XN + (size_t)M * D * 2 <= WS_ACT && WS_ACT + (size_t)M * FF * 2 <= WS_F &&
              WS_MV + (size_t)M * HW * 2 <= WS_F && WS_F + (size_t)M * HW * 4 <= WS_ORAW && WS_ORAW + (size_t)M * HW * 4 <= WS_END, "d_ws map");
constexpr int CW_TMO = 0, CW_CODE = 1;
constexpr int CW_BAR = 4096;

constexpr int RING_OFF = 0, RING_BYTES = 131072;
constexpr int LDSCTL_OFF = RING_BYTES, MISC_OFF = LDSCTL_OFF + 320;
constexpr int LDS_BYTES = 147456;
static_assert(MISC_OFF + 128 <= LDS_BYTES, "LDS map");

#define GAS __attribute__((address_space(1)))
#define LAS __attribute__((address_space(3)))
typedef unsigned short bf16;
typedef unsigned v4u __attribute__((ext_vector_type(4)));
typedef float f32x4 __attribute__((ext_vector_type(4)));
typedef short bf16x8 __attribute__((ext_vector_type(8)));
typedef GAS unsigned gu32;
typedef GAS unsigned long long gu64;
#define RLX_AGENT __ATOMIC_RELAXED, __HIP_MEMORY_SCOPE_AGENT
#define LDS_WAIT() asm volatile("s_waitcnt lgkmcnt(0)" ::: "memory")
#define VM_WAIT() asm volatile("s_waitcnt vmcnt(0)" ::: "memory")
__device__ __forceinline__ unsigned long long rt() { return __builtin_amdgcn_s_memrealtime(); }
__device__ __forceinline__ unsigned f2bf(float f) { unsigned u = __builtin_bit_cast(unsigned, f); return (u + 0x7fffu + ((u >> 16) & 1u)) >> 16; }
__device__ __forceinline__ unsigned pk2(float lo, float hi) { return f2bf(lo) | (f2bf(hi) << 16); }

#define XB_TMO      128
#define XB_XCNT(j)  (256  + 64 * (j))
#define XB_XSUB(j)  (1280 + 64 * (j))
#define XB_XGEN(j)  (2304 + 64 * (j))
#define XB_TOP      3328
#define XB_TOPGEN   3392
#define XCD_BAR_WORDS 3456
#define XB_SPIN_CAP (1u << 18)

__device__ __forceinline__ unsigned xb_ld(unsigned* p)              { return __hip_atomic_load(p, __ATOMIC_RELAXED, __HIP_MEMORY_SCOPE_AGENT); }
__device__ __forceinline__ unsigned xb_add(unsigned* p, unsigned v) { return __hip_atomic_fetch_add(p, v, __ATOMIC_RELAXED, __HIP_MEMORY_SCOPE_AGENT); }
__device__ __forceinline__ unsigned xb_xcc_id() { return (unsigned)__builtin_amdgcn_s_getreg((3 << 11) | 20) & 0xFu; }
#define XB_SPIN(cond, bar) do { unsigned _sp = 0; while (cond) { __builtin_amdgcn_s_sleep(1); \
    if ((++_sp & 255u) == 0u) { if (xb_ld(&(bar)[XB_TMO])) break; if (_sp > XB_SPIN_CAP) { atomicAdd(&(bar)[XB_TMO], 1u); break; } } } } while (0)

struct XcdBarrier {
    unsigned* bar; unsigned x;
    volatile LAS unsigned* st;
};

__device__ __forceinline__ XcdBarrier xcd_barrier_post(unsigned* bar, volatile LAS unsigned* st) {
    XcdBarrier b; b.bar = bar; b.x = xb_xcc_id(); b.st = st;
    if (threadIdx.x == 0) (void)xb_add(&bar[XB_XCNT(b.x)], 1u);
    return b;
}
__device__ __forceinline__ void xcd_barrier_complete(unsigned* bar, unsigned x, unsigned& nloc, unsigned& nx) {
    const unsigned G = gridDim.x * gridDim.y * gridDim.z;
    unsigned sum, cnt, mine, sp = 0u;
    for (;;) {
        sum = 0u; cnt = 0u; mine = 0u;
#pragma unroll
        for (unsigned j = 0; j < 16; ++j) { const unsigned c = xb_ld(&bar[XB_XCNT(j)]); sum += c; cnt += (c > 0u) ? 1u : 0u; mine = (j == x) ? c : mine; }
        if (sum == G) break;
        __builtin_amdgcn_s_sleep(1);
        if ((++sp & 255u) == 0u) { if (xb_ld(&bar[XB_TMO])) break; if (sp > XB_SPIN_CAP) { atomicAdd(&bar[XB_TMO], 1u); break; } }
    }
    nloc = mine > 0u ? mine : 1u; nx = cnt > 0u ? cnt : 1u;
}

__device__ __forceinline__ void xcd_barrier(const XcdBarrier& b) {
    asm volatile("s_waitcnt vmcnt(0)" ::: "memory");
    __syncthreads();
    if (threadIdx.x == 0) {
        unsigned* bar = b.bar;
        __builtin_amdgcn_s_waitcnt(0);
        unsigned nloc = b.st[0], nx = b.st[1];
        if (nloc == 0u) { xcd_barrier_complete(bar, b.x, nloc, nx); b.st[0] = nloc; b.st[1] = nx; }
        const unsigned old = xb_add(&bar[XB_XSUB(b.x)], 1u);
        const unsigned gen = old / nloc;
        if (old + 1u == (gen + 1u) * nloc) {
            __builtin_amdgcn_fence(__ATOMIC_RELEASE, "agent");
            asm volatile("s_waitcnt vmcnt(0)" ::: "memory");
            const unsigned og = xb_add(&bar[XB_TOP], 1u);
            const unsigned tg = og / nx;
            if (og + 1u == (tg + 1u) * nx) xb_add(&bar[XB_TOPGEN], 1u);
            else XB_SPIN(xb_ld(&bar[XB_TOPGEN]) == tg, bar);
            __builtin_amdgcn_fence(__ATOMIC_ACQUIRE, "agent");
            xb_add(&bar[XB_XGEN(b.x)], 1u);
            asm volatile("s_waitcnt vmcnt(0)" ::: "memory");
        } else {
            XB_SPIN(xb_ld(&bar[XB_XGEN(b.x)]) == gen, bar);
            __builtin_amdgcn_fence(__ATOMIC_ACQUIRE, "agent");
            asm volatile("s_waitcnt vmcnt(0)" ::: "memory");
        }
    }
    __syncthreads();
}

typedef float f32x16 __attribute__((ext_vector_type(16)));
typedef short s16x4 __attribute__((ext_vector_type(4)));
typedef unsigned v2u __attribute__((ext_vector_type(2)));
struct Frame {
    LAS unsigned char* lds;
    volatile LAS unsigned* MISC;
    gu32* ctl;
    int tid, lane, wave;
    int vcu, G;
    const float* x; float* out;
    const float *n1, *wg1, *wu1, *wd1, *nmix, *win, *lbnd, *hnorm, *wout, *n2, *wg2, *wu2, *wd2, *nfin;
    bf16 *WGU1, *WD1, *WIN, *WOUT, *WGU2, *WD2;
    bf16 *XN, *ACT, *QH, *VH, *GH, *MQ, *MK, *MV;
    float *FG, *ORAW, *KMEAN;
};

__device__ __forceinline__ float wave_sum(float v) {
#pragma unroll
    for (int o = 1; o < 64; o <<= 1) v += __shfl_xor(v, o);
    return v;
}
__device__ __forceinline__ float bf_lo(unsigned w) { return __builtin_bit_cast(float, w << 16); }
__device__ __forceinline__ float bf_hi(unsigned w) { return __builtin_bit_cast(float, w & 0xffff0000u); }

__device__ __forceinline__ void p0_transpose_item(const float* W, int K, int N, bf16* WT, int mode, LAS float* scr, int item, int lane) {
    const int nblk = N / 32, kb = item / nblk, nb = item % nblk, k0 = 64 * kb, n0 = 32 * nb;
    const int rbase = (mode == 0) ? n0 : (256 * (n0 >> 7) + (n0 & 127) + (mode == 2 ? 128 : 0));
#pragma unroll 8
    for (int i = 0; i < 32; ++i) { const int kk = 2 * i + (lane >> 5); scr[kk * 33 + (lane & 31)] = W[(size_t)(k0 + kk) * N + n0 + (lane & 31)]; }
    LDS_WAIT(); asm volatile("" ::: "memory");
    const int c = lane & 7;
#pragma unroll
    for (int j = 0; j < 4; ++j) { const int n = (lane >> 3) + 8 * j; const LAS float* s = scr + (8 * c) * 33 + n;
        v4u o; o.x = pk2(s[0 * 33], s[1 * 33]); o.y = pk2(s[2 * 33], s[3 * 33]); o.z = pk2(s[4 * 33], s[5 * 33]); o.w = pk2(s[6 * 33], s[7 * 33]);
        *(GAS v4u*)(WT + (size_t)(rbase + n) * K + k0 + 8 * c) = o; }
    LDS_WAIT(); asm volatile("" ::: "memory");
}
__device__ __forceinline__ void rms_row_bf16(const float* xrow, const float* g, bf16* orow, int lane) {
    const GAS f32x4* xr = (const GAS f32x4*)xrow + lane; const GAS f32x4* gr = (const GAS f32x4*)g + lane;
    f32x4 v[16]; float s = 0.f;
#pragma unroll
    for (int j = 0; j < 16; ++j) { v[j] = xr[64 * j]; s += (v[j].x * v[j].x + v[j].y * v[j].y) + (v[j].z * v[j].z + v[j].w * v[j].w); }
    const float r = 1.f / sqrtf(wave_sum(s) * (1.f / D) + RMS_EPS);
    GAS v2u* o8 = (GAS v2u*)orow + lane;
#pragma unroll
    for (int j = 0; j < 16; ++j) { const f32x4 gv = gr[64 * j]; v2u w; w.x = pk2(v[j].x * r * gv.x, v[j].y * r * gv.y); w.y = pk2(v[j].z * r * gv.z, v[j].w * r * gv.w); o8[64 * j] = w; }
}
__device__ __forceinline__ void rms_row_f32(const float* xrow, const float* g, float* orow, int lane) {
    const GAS f32x4* xr = (const GAS f32x4*)xrow + lane; const GAS f32x4* gr = (const GAS f32x4*)g + lane;
    f32x4 v[16]; float s = 0.f;
#pragma unroll
    for (int j = 0; j < 16; ++j) { v[j] = xr[64 * j]; s += (v[j].x * v[j].x + v[j].y * v[j].y) + (v[j].z * v[j].z + v[j].w * v[j].w); }
    const float r = 1.f / sqrtf(wave_sum(s) * (1.f / D) + RMS_EPS);
    GAS f32x4* o = (GAS f32x4*)orow + lane;
#pragma unroll
    for (int j = 0; j < 16; ++j) { const f32x4 gv = gr[64 * j]; o[64 * j] = (v[j] * r) * gv; }
}
__device__ __forceinline__ void norm_phase_bf16(Frame& F, const float* src, const float* g, bf16* dst) {
    const int gw = F.vcu * NWAVES + F.wave, NGW = F.G * NWAVES;
    for (int m = gw; m < M; m += NGW) rms_row_bf16(src + (size_t)m * D, g, dst + (size_t)m * D, F.lane);
}
__device__ __forceinline__ void p0_prologue(Frame& F) {
    LAS float* scr = (LAS float*)(F.lds + RING_OFF + F.wave * 16384);
    const int gw = F.vcu * NWAVES + F.wave, NGW = F.G * NWAVES;
    constexpr int I_GU = (D / 64) * (FF / 32), I_DN = (FF / 64) * (D / 32), I_IN = (D / 64) * (NIN / 32), I_OUT = (D / 64) * (D / 32);
    constexpr int NITEMS = 4 * I_GU + 2 * I_DN + I_IN + I_OUT;
    for (int it = gw; it < NITEMS; it += NGW) {
        int r = it;
        if (r < I_GU) { p0_transpose_item(F.wg1, D, FF, F.WGU1, 1, scr, r, F.lane); continue; } r -= I_GU;
        if (r < I_GU) { p0_transpose_item(F.wu1, D, FF, F.WGU1, 2, scr, r, F.lane); continue; } r -= I_GU;
        if (r < I_DN) { p0_transpose_item(F.wd1, FF, D, F.WD1, 0, scr, r, F.lane); continue; } r -= I_DN;
        if (r < I_IN) { p0_transpose_item(F.win, D, NIN, F.WIN, 0, scr, r, F.lane); continue; } r -= I_IN;
        if (r < I_OUT) { p0_transpose_item(F.wout, D, D, F.WOUT, 0, scr, r, F.lane); continue; } r -= I_OUT;
        if (r < I_GU) { p0_transpose_item(F.wg2, D, FF, F.WGU2, 1, scr, r, F.lane); continue; } r -= I_GU;
        if (r < I_GU) { p0_transpose_item(F.wu2, D, FF, F.WGU2, 2, scr, r, F.lane); continue; } r -= I_GU;
        p0_transpose_item(F.wd2, FF, D, F.WD2, 0, scr, r, F.lane);
    }
    norm_phase_bf16(F, F.x, F.n1, F.XN);
}

__device__ __forceinline__ void kmean_phase(Frame& F) {
    const int gw = F.vcu * NWAVES + F.wave, NGW = F.G * NWAVES, rg = F.lane >> 4, c8 = F.lane & 15;
    for (int item = gw; item < BATCH * 16 * NHEAD; item += NGW) {
        const int b = item >> 8, n = (item >> 4) & 15, h = item & 15;
        const bf16* base = F.MK + ((size_t)(b * SEQ + n * 256 + rg)) * HW + h * HD + 8 * c8;
        float s[8];
#pragma unroll
        for (int k = 0; k < 8; ++k) s[k] = 0.f;
#pragma unroll 8
        for (int i = 0; i < 64; ++i) { const v4u w = *(const GAS v4u*)(base + (size_t)(4 * i) * HW);
            s[0] += bf_lo(w.x); s[1] += bf_hi(w.x); s[2] += bf_lo(w.y); s[3] += bf_hi(w.y); s[4] += bf_lo(w.z); s[5] += bf_hi(w.z); s[6] += bf_lo(w.w); s[7] += bf_hi(w.w); }
#pragma unroll
        for (int k = 0; k < 8; ++k) { s[k] += __shfl_xor(s[k], 16); s[k] += __shfl_xor(s[k], 32); s[k] *= (1.f / 256.f); }
        if (F.lane < 16) { GAS f32x4* o = (GAS f32x4*)(F.KMEAN + ((size_t)((b * 16 + h) * 16 + n)) * HD + 8 * c8);
            o[0] = (f32x4){s[0], s[1], s[2], s[3]}; o[1] = (f32x4){s[4], s[5], s[6], s[7]}; }
    }
}
constexpr int HG_F = 0, HG_Q = 32768, HG_V = 49152, HG_BUF = 53248;
static_assert(2 * HG_BUF <= RING_BYTES, "hgrn LDS");
__device__ __forceinline__ void hgrn_scan_phase(Frame& F) {
    const int tid = F.tid, lane = F.lane, wave = F.wave, g = lane >> 2, c = lane & 3;
    for (int unit = F.vcu; unit < BATCH * NHEAD * 4; unit += F.G) {
        const int bh = unit >> 2, vq = unit & 3, b = bh >> 4, h = bh & 15;
        const size_t row0 = (size_t)b * SEQ;
        const float* Fg = F.FG + row0 * HW + h * HD; const bf16* Qg = F.QH + row0 * HW + h * HD; const bf16* Vg = F.VH + row0 * HW + h * HD + vq * 32;
        float* Og = F.ORAW + row0 * HW + h * HD + vq * 32 + 4 * wave + c;
        f32x4 sf[4]; v4u sq[2]; v4u sv;
#define HG_LOAD(ch) do { _Pragma("unroll") for (int i_ = 0; i_ < 4; ++i_) { const int idx_ = tid + 512 * i_; sf[i_] = *(const GAS f32x4*)(Fg + (size_t)((ch) * 64 + (idx_ >> 5)) * HW + (idx_ & 31) * 4); } \
        _Pragma("unroll") for (int i_ = 0; i_ < 2; ++i_) { const int idx_ = tid + 512 * i_; sq[i_] = *(const GAS v4u*)(Qg + (size_t)((ch) * 64 + (idx_ >> 4)) * HW + (idx_ & 15) * 8); } \
        if (tid < 256) sv = *(const GAS v4u*)(Vg + (size_t)((ch) * 64 + (tid >> 2)) * HW + (tid & 3) * 8); } while (0)
#define HG_WRITE(bf) do { LAS unsigned char* b_ = F.lds + RING_OFF + (bf) * HG_BUF; \
        _Pragma("unroll") for (int i_ = 0; i_ < 4; ++i_) { const int idx_ = tid + 512 * i_; *(LAS f32x4*)(b_ + HG_F + (idx_ >> 5) * 512 + (idx_ & 31) * 16) = sf[i_]; } \
        _Pragma("unroll") for (int i_ = 0; i_ < 2; ++i_) { const int idx_ = tid + 512 * i_; *(LAS v4u*)(b_ + HG_Q + (idx_ >> 4) * 256 + (idx_ & 15) * 16) = sq[i_]; } \
        if (tid < 256) *(LAS v4u*)(b_ + HG_V + (tid >> 2) * 64 + (tid & 3) * 16) = sv; } while (0)
        float S[8];
#pragma unroll
        for (int i = 0; i < 8; ++i) S[i] = 0.f;
        HG_LOAD(0); VM_WAIT(); HG_WRITE(0); LDS_WAIT(); __syncthreads();
        for (int ch = 0; ch < SEQ / 64; ++ch) {
            const int bf = ch & 1;
            if (ch + 1 < SEQ / 64) HG_LOAD(ch + 1);
            const LAS unsigned char* bp = F.lds + RING_OFF + bf * HG_BUF;
            const LAS unsigned char* fp = bp + HG_F + g * 32; const LAS unsigned char* qp = bp + HG_Q + g * 16; const LAS unsigned char* vp = bp + HG_V + (4 * wave + c) * 2;
            for (int t0 = 0; t0 < 64; t0 += 16) {
                float p[16];
#pragma unroll
                for (int s = 0; s < 16; ++s) { const int t = t0 + s;
                    const f32x4 fa = *(const LAS f32x4*)(fp + t * 512), fb = *(const LAS f32x4*)(fp + t * 512 + 16); const v4u qw = *(const LAS v4u*)(qp + t * 256);
                    const float v = __builtin_bit_cast(float, (unsigned)(*(const LAS unsigned short*)(vp + t * 64)) << 16);
                    const float f[8] = {fa.x, fa.y, fa.z, fa.w, fb.x, fb.y, fb.z, fb.w};
                    const float q[8] = {bf_lo(qw.x), bf_hi(qw.x), bf_lo(qw.y), bf_hi(qw.y), bf_lo(qw.z), bf_hi(qw.z), bf_lo(qw.w), bf_hi(qw.w)};
                    float o = 0.f;
#pragma unroll
                    for (int i = 0; i < 8; ++i) { S[i] = v + f[i] * (S[i] - v); o += S[i] * q[i]; }
                    p[s] = o; }
                float p8[8], p4[4], p2[2], p1;
#pragma unroll
                for (int s = 0; s < 8; ++s) { const float mine = (g & 8) ? p[s + 8] : p[s], send = (g & 8) ? p[s] : p[s + 8]; p8[s] = mine + __shfl_xor(send, 32); }
#pragma unroll
                for (int s = 0; s < 4; ++s) { const float mine = (g & 4) ? p8[s + 4] : p8[s], send = (g & 4) ? p8[s] : p8[s + 4]; p4[s] = mine + __shfl_xor(send, 16); }
#pragma unroll
                for (int s = 0; s < 2; ++s) { const float mine = (g & 2) ? p4[s + 2] : p4[s], send = (g & 2) ? p4[s] : p4[s + 2]; p2[s] = mine + __shfl_xor(send, 8); }
                { const float mine = (g & 1) ? p2[1] : p2[0], send = (g & 1) ? p2[0] : p2[1]; p1 = mine + __shfl_xor(send, 4); }
                Og[(size_t)(ch * 64 + t0 + g) * HW] = p1;
            }
            if (ch + 1 < SEQ / 64) { VM_WAIT(); HG_WRITE(bf ^ 1); }
            LDS_WAIT(); __syncthreads();
        }
#undef HG_LOAD
#undef HG_WRITE
    }
}
__device__ __forceinline__ void hgrn_post_phase(Frame& F) {
    const int gw = F.vcu * NWAVES + F.wave, NGW = F.G * NWAVES, lane = F.lane;
    const f32x4 gn = *(const GAS f32x4*)(F.hnorm + ((4 * lane) & 127));
    for (int m = gw; m < M; m += NGW) {
        const GAS f32x4* orow = (const GAS f32x4*)(F.ORAW + (size_t)m * HW) + lane; const GAS v2u* grow = (const GAS v2u*)(F.GH + (size_t)m * HW) + lane;
        GAS v2u* dst = (GAS v2u*)(F.XN + (size_t)m * D) + lane;
        f32x4 v[8]; v2u gw2[8];
#pragma unroll
        for (int j = 0; j < 8; ++j) { v[j] = orow[64 * j]; gw2[j] = grow[64 * j]; }
#pragma unroll
        for (int j = 0; j < 8; ++j) { float s = (v[j].x * v[j].x + v[j].y * v[j].y) + (v[j].z * v[j].z + v[j].w * v[j].w);
#pragma unroll
            for (int o = 1; o < 32; o <<= 1) s += __shfl_xor(s, o);
            const float r = 1.f / sqrtf(s * (1.f / HD) + RMS_EPS);
            v2u w; w.x = pk2((v[j].x * r) * gn.x * bf_lo(gw2[j].x), (v[j].y * r) * gn.y * bf_hi(gw2[j].x)); w.y = pk2((v[j].z * r) * gn.z * bf_lo(gw2[j].y), (v[j].w * r) * gn.w * bf_hi(gw2[j].y));
            dst[64 * j] = w; }
    }
}


namespace moba {
#define KSWZ(row, colB) ((row) * 256 + ((colB) ^ (((row) & 7) << 4)))
#define SBAR() __builtin_amdgcn_sched_barrier(0)
constexpr int SHM_K = 16384, SHM_V = 16384;
constexpr int V_OFF = 0, K_OFF = 2 * SHM_V, WS_OFF = K_OFF + 2 * SHM_K, G_OFF = WS_OFF + NWAVES * 256, LDS_END = G_OFF + 32 * 256;
static_assert(LDS_END <= RING_BYTES, "moba LDS");
__device__ __forceinline__ int v_st(int k, int c) { const int kk = (k & ~0xC) | ((k & 4) << 1) | ((k & 8) >> 1); return ((kk >> 3) * 4 + (c >> 5)) * 512 + ((kk & 7) * 32 + (c & 31)) * 2; }
__device__ __forceinline__ int v_rd_base(int lane) { return ((lane & 3) << 3) | (((lane >> 2) & 3) << 6) | (((lane >> 4) & 1) << 5) | (((lane >> 5) & 1) << 8); }
constexpr int v_rd_off(int d0, int ks, int half) { return d0 * 512 + ks * 4096 + half * 2048; }
__device__ __forceinline__ int crow(int r, int hi) { return (r & 3) + 8 * (r >> 2) + 4 * hi; }
__device__ __forceinline__ unsigned cvtpk(float lo, float hi) { unsigned r; asm volatile("v_cvt_pk_bf16_f32 %0, %1, %2" : "=v"(r) : "v"(lo), "v"(hi)); return r; }

template <int KB>
__device__ __forceinline__ void qkt(f32x16& p0, f32x16& p1, const LAS unsigned char* K_lds, int r32, int hi, const bf16x8* qr) {
    const LAS unsigned char* kb[4];
#pragma unroll
    for (int dd = 0; dd < 4; ++dd) kb[dd] = K_lds + KB * SHM_K + KSWZ(r32, (dd * 16 + hi * 8) * 2);
#pragma unroll
    for (int d0 = 0; d0 < 8; ++d0) { const LAS unsigned char* a = kb[d0 & 3] + (d0 >> 2) * 128;
        const bf16x8 b0 = *(const LAS bf16x8*)a;
        const bf16x8 b1 = *(const LAS bf16x8*)(a + 32 * 256);
        p0 = __builtin_amdgcn_mfma_f32_32x32x16_bf16(b0, qr[d0], p0, 0, 0, 0);
        p1 = __builtin_amdgcn_mfma_f32_32x32x16_bf16(b1, qr[d0], p1, 0, 0, 0);
        if (d0 & 1) SBAR(); }
}
template <int VB>
__device__ __forceinline__ void pv_tile(f32x16* o, int vb0, bf16x8 pa0, bf16x8 pa1, bf16x8 pa2, bf16x8 pa3) {
#define TRRD(dst, off) asm volatile("ds_read_b64_tr_b16 %0, %1 offset:%2" : "=&v"(dst) : "v"(vb0), "i"(off) : "memory")
#define PV_D0(d0) do { s16x4 l0, l1, l2, l3, h0, h1, h2, h3; constexpr int b_ = VB * SHM_V + v_rd_off(d0, 0, 0); \
        TRRD(l0, b_); TRRD(h0, b_ + 2048); TRRD(l1, b_ + 4096); TRRD(h1, b_ + 6144); TRRD(l2, b_ + 8192); TRRD(h2, b_ + 10240); TRRD(l3, b_ + 12288); TRRD(h3, b_ + 14336); \
        asm volatile("s_waitcnt lgkmcnt(0)" ::: "memory"); SBAR(); \
        o[d0] = __builtin_amdgcn_mfma_f32_32x32x16_bf16(pa0, (bf16x8){l0[0], l0[1], l0[2], l0[3], h0[0], h0[1], h0[2], h0[3]}, o[d0], 0, 0, 0);   \
        o[d0] = __builtin_amdgcn_mfma_f32_32x32x16_bf16(pa1, (bf16x8){l1[0], l1[1], l1[2], l1[3], h1[0], h1[1], h1[2], h1[3]}, o[d0], 0, 0, 0);   \
        o[d0] = __builtin_amdgcn_mfma_f32_32x32x16_bf16(pa2, (bf16x8){l2[0], l2[1], l2[2], l2[3], h2[0], h2[1], h2[2], h2[3]}, o[d0], 0, 0, 0);   \
        o[d0] = __builtin_amdgcn_mfma_f32_32x32x16_bf16(pa3, (bf16x8){l3[0], l3[1], l3[2], l3[3], h3[0], h3[1], h3[2], h3[3]}, o[d0], 0, 0, 0); } while (0)
    PV_D0(0); PV_D0(1); PV_D0(2); PV_D0(3);
#undef PV_D0
#undef TRRD
}

__device__ __forceinline__ void unit(LAS unsigned char* lds, const bf16* MQ, const bf16* MK, const bf16* MV, const float* KMEAN, bf16* MIX, int b, int h, int j) {
    int tid = threadIdx.x; asm volatile("" : "+v"(tid));
    const int wid = __builtin_amdgcn_readfirstlane(tid >> 6), lane = tid & 63, r32 = lane & 31, hi = lane >> 5;
    LAS unsigned char* V_lds = lds + V_OFF; LAS unsigned char* K_lds = lds + K_OFF; LAS unsigned char* G_lds = lds + G_OFF;
    LAS float* wsx = (LAS float*)(lds + WS_OFF) + wid * 64; LAS float* li_l = wsx; LAS float* al_l = wsx + 32;
    const int sr = tid >> 4, sc = (tid & 15) * 8, vst0 = v_st(sr, sc), vst1 = v_st(32 + sr, sc), kws = KSWZ(sr, sc * 2);
    const int vb0 = (int)(uintptr_t)V_lds + v_rd_base(lane);
    const size_t rowb = (size_t)b * SEQ;
    const bf16* Kh = MK + rowb * HW + h * HD + sc; const bf16* Vh = MV + rowb * HW + h * HD + sc;
    const float slope2 = 1.4426950408889634f * __builtin_amdgcn_exp2f(-0.5f * (float)(h + 1));
    const int NT = 4 * (j + 1);
    bf16x8 st_k0, st_k1, st_v0, st_v1;
#define TLOAD(t) do { const size_t r_ = (size_t)((t) * 64 + sr) * HW; st_k0 = *(const GAS bf16x8*)(Kh + r_); st_k1 = *(const GAS bf16x8*)(Kh + r_ + (size_t)32 * HW); \
                      st_v0 = *(const GAS bf16x8*)(Vh + r_); st_v1 = *(const GAS bf16x8*)(Vh + r_ + (size_t)32 * HW); } while (0)
#define TWRITE(bf) do { *(LAS bf16x8*)(K_lds + (bf) * SHM_K + kws) = st_k0; *(LAS bf16x8*)(K_lds + (bf) * SHM_K + kws + 32 * 256) = st_k1; \
                        *(LAS bf16x8*)(V_lds + (bf) * SHM_V + vst0) = st_v0; *(LAS bf16x8*)(V_lds + (bf) * SHM_V + vst1) = st_v1; } while (0)
    bf16x8 qr[8];
    { const bf16* qrow = MQ + (rowb + (size_t)(j * 256 + wid * 32 + r32)) * HW + h * HD + hi * 8;
#pragma unroll
      for (int d0 = 0; d0 < 8; ++d0) qr[d0] = *(const GAS bf16x8*)(qrow + d0 * 16); }
    { const int n = tid >> 5, d4 = (tid & 31) * 4; const f32x4 km = *(const GAS f32x4*)(KMEAN + ((size_t)((b * NHEAD + h) * 16 + n)) * HD + d4);
      const unsigned h0 = f2bf(km.x), h1 = f2bf(km.y), h2 = f2bf(km.z), h3 = f2bf(km.w);
      const float l0 = km.x - __builtin_bit_cast(float, h0 << 16), l1 = km.y - __builtin_bit_cast(float, h1 << 16), l2 = km.z - __builtin_bit_cast(float, h2 << 16), l3 = km.w - __builtin_bit_cast(float, h3 << 16);
      v2u whi, wlo; whi.x = h0 | (h1 << 16); whi.y = h2 | (h3 << 16); wlo.x = pk2(l0, l1); wlo.y = pk2(l2, l3);
      *(LAS v2u*)(G_lds + KSWZ(n, d4 * 2)) = whi; *(LAS v2u*)(G_lds + KSWZ(16 + n, d4 * 2)) = wlo; }
    TLOAD(0); VM_WAIT(); TWRITE(0); LDS_WAIT(); __syncthreads();
    unsigned sel = 0u;
    if (j > 0) {
        f32x16 gp = {};
#pragma unroll
        for (int d0 = 0; d0 < 8; ++d0) { const bf16x8 a = *(const LAS bf16x8*)(G_lds + KSWZ(r32, (d0 * 16 + hi * 8) * 2)); gp = __builtin_amdgcn_mfma_f32_32x32x16_bf16(a, qr[d0], gp, 0, 0, 0); }
        float gm[8], go[8]; int nm[8];
        const float NEG = -__builtin_inff(); const bool hi1 = (hi != 0);
#pragma unroll
        for (int r = 0; r < 8; ++r) { nm[r] = (r & 3) + 8 * (r >> 2) + 4 * hi;
            const float gv = gp[r] + gp[r + 8]; gm[r] = (nm[r] < j) ? gv : NEG; }
#pragma unroll
        for (int r = 0; r < 8; ++r) go[r] = __shfl_xor(gm[r], 32);
        unsigned mine = 0u;
#pragma unroll
        for (int r = 0; r < 8; ++r) { int rank = 0;
#pragma unroll
            for (int q = 0; q < 8; ++q) {
                if (q != r) rank += (gm[q] > gm[r] || (gm[q] == gm[r] && q < r)) ? 1 : 0;
                const bool lower = ((q >> 2) < (r >> 2)) || (((q >> 2) == (r >> 2)) && hi1);
                rank += (go[q] > gm[r] || (go[q] == gm[r] && lower)) ? 1 : 0; }
            if (nm[r] < j && rank < 3) mine |= 1u << nm[r]; }
        sel = mine | (unsigned)__shfl_xor((int)mine, 32);
    }
    const float sl1 = slope2, sl2 = 2.f * slope2, sl3 = 3.f * slope2, sl8 = 8.f * slope2, slh = slope2 * (float)(4 * hi);
    const int tq = wid * 32 + r32;
    float m_reg = -1e30f, l_reg = 0.f; f32x16 o[4] = {};
    f32x16 p0, p1; bf16x8 pa0, pa1, pa2, pa3;
    const float NEGI = -__builtin_inff();
#define RESC(a) do { if (__any((a) < 1.f)) { if (hi == 0) al_l[r32] = (a); asm volatile("s_waitcnt lgkmcnt(0)" ::: "memory");              \
                     _Pragma("unroll") for (int d_ = 0; d_ < 4; ++d_) _Pragma("unroll") for (int r = 0; r < 16; ++r) o[d_][r] *= al_l[crow(r, hi)]; } } while (0)
#define PK4(P, B_, OUT) do { unsigned a0 = cvtpk(P[B_+0], P[B_+1]), a1 = cvtpk(P[B_+2], P[B_+3]);                          \
        unsigned b0 = cvtpk(P[B_+4], P[B_+5]), b1 = cvtpk(P[B_+6], P[B_+7]);                                             \
        auto r0 = __builtin_amdgcn_permlane32_swap(a0, b0, false, false); auto r1 = __builtin_amdgcn_permlane32_swap(a1, b1, false, false); \
        v4u w = {r0[0], r1[0], r0[1], r1[1]}; OUT = *reinterpret_cast<bf16x8*>(&w); } while (0)
#define TILE_STEP(t, KB) do { const int n_ = (t) >> 2, tt_ = (t) & 3; \
        if ((t) + 1 < NT) TLOAD((t) + 1); \
        const bool own_ = (n_ == j); \
        const bool act_ = !(own_ && 64 * tt_ > wid * 32 + 31);             \
        if (act_) { \
            const float bi_ = slope2 * (float)(256 * (n_ - j) + 64 * tt_) + slh; \
            _Pragma("unroll") for (int k_ = 0; k_ < 8; ++k_) { const float bk_ = bi_ + sl8 * (float)k_; \
                if (k_ < 4) { p0[4 * k_] = bk_; p0[4 * k_ + 1] = bk_ + sl1; p0[4 * k_ + 2] = bk_ + sl2; p0[4 * k_ + 3] = bk_ + sl3; } \
                else { p1[4 * k_ - 16] = bk_; p1[4 * k_ - 15] = bk_ + sl1; p1[4 * k_ - 14] = bk_ + sl2; p1[4 * k_ - 13] = bk_ + sl3; } } \
            qkt<KB>(p0, p1, K_lds, r32, hi, qr); \
            if (own_) { const int dq_ = tq - 64 * tt_ - 4 * hi; \
                _Pragma("unroll") for (int r = 0; r < 16; ++r) { const int c_ = (r & 3) + 8 * (r >> 2); if (dq_ - c_ < 0) p0[r] = NEGI; if (dq_ - c_ - 32 < 0) p1[r] = NEGI; } } \
            else { const bool on_ = ((sel >> n_) & 1u) != 0u; \
                _Pragma("unroll") for (int r = 0; r < 16; ++r) { p0[r] = on_ ? p0[r] : NEGI; p1[r] = on_ ? p1[r] : NEGI; } } \
            float pmax_ = p0[0]; \
            _Pragma("unroll") for (int r = 1; r < 16; ++r) pmax_ = fmaxf(pmax_, p0[r]); \
            _Pragma("unroll") for (int r = 0; r < 16; ++r) pmax_ = fmaxf(pmax_, p1[r]); \
            { auto rr_ = __builtin_amdgcn_permlane32_swap(__float_as_uint(pmax_), __float_as_uint(pmax_), false, false); pmax_ = fmaxf(__uint_as_float(rr_[0]), __uint_as_float(rr_[1])); } \
            const float mn_ = fmaxf(m_reg, pmax_); const float alpha_ = __builtin_amdgcn_exp2f(m_reg - mn_); m_reg = mn_; \
            _Pragma("unroll") for (int r = 0; r < 16; ++r) { p0[r] = __builtin_amdgcn_exp2f(p0[r] - mn_); p1[r] = __builtin_amdgcn_exp2f(p1[r] - mn_); } \
            float ps_ = 0.f; \
            _Pragma("unroll") for (int r = 0; r < 16; ++r) ps_ += p0[r]; \
            _Pragma("unroll") for (int r = 0; r < 16; ++r) ps_ += p1[r]; \
            { auto rr_ = __builtin_amdgcn_permlane32_swap(__float_as_uint(ps_), __float_as_uint(ps_), false, false); ps_ = __uint_as_float(rr_[0]) + __uint_as_float(rr_[1]); } \
            l_reg = l_reg * alpha_ + ps_; \
            RESC(alpha_); \
            PK4(p0, 0, pa0); PK4(p0, 8, pa1); PK4(p1, 0, pa2); PK4(p1, 8, pa3); \
            pv_tile<KB>(o, vb0, pa0, pa1, pa2, pa3); \
        } \
        if ((t) + 1 < NT) { VM_WAIT(); TWRITE((KB) ^ 1); } \
        LDS_WAIT(); __syncthreads(); } while (0)
    for (int t = 0; t < NT; t += 2) { TILE_STEP(t, 0); TILE_STEP(t + 1, 1); }
    if (hi == 0) li_l[r32] = l_reg; asm volatile("s_waitcnt lgkmcnt(0)" ::: "memory");
    float rli[16];
#pragma unroll
    for (int r = 0; r < 16; ++r) rli[r] = __builtin_amdgcn_rcpf(li_l[crow(r, hi)]);
    bf16* Ow = MIX + (rowb + (size_t)(j * 256 + wid * 32)) * D + HW + h * HD;
#pragma unroll
    for (int r = 0; r < 16; ++r) { const int orow = crow(r, hi);
#pragma unroll
        for (int d0 = 0; d0 < 4; ++d0) { const float v = o[d0][r] * rli[r]; const float vn = __shfl_xor(v, 1);
            if ((r32 & 1) == 0) *(GAS unsigned*)(Ow + (size_t)orow * D + d0 * 32 + r32) = cvtpk(v, vn); } }
    LDS_WAIT(); __syncthreads();
#undef TLOAD
#undef TWRITE
#undef RESC
#undef PK4
#undef TILE_STEP
}
#undef KSWZ
#undef SBAR
}
__device__ __forceinline__ void moba_phase(Frame& F) {
    for (int p = F.vcu; p < BATCH * NHEAD * 8; p += F.G) {
        const int bh = p >> 3, s = p & 7, b = bh >> 4, h = bh & 15;
        for (int k = 0; k < 2; ++k) moba::unit(F.lds + RING_OFF, F.MQ, F.MK, F.MV, F.KMEAN, F.XN, b, h, k ? s : 15 - s);
    }
}


struct Args { const float* in[15]; float* out; unsigned char* ws; int ph_lo, ph_hi, li, pad; };
__global__ void __launch_bounds__(NWAVES * 64, 2) mk_fwd(Args args) {
    extern __shared__ __attribute__((aligned(16))) unsigned char lds[];
    Frame F;
    F.lds = (LAS unsigned char*)lds;
    F.MISC = (volatile LAS unsigned*)(F.lds + MISC_OFF);
    F.tid = threadIdx.x; F.lane = F.tid & 63; F.wave = __builtin_amdgcn_readfirstlane(F.tid >> 6);
    F.G = gridDim.x; { const int bx = blockIdx.x; F.vcu = (F.G % 8 == 0) ? (bx % 8) * (F.G / 8) + bx / 8 : bx; }
#define GRID_BAR(seam) do { if (N_LAUNCHES == PER_PHASE) { if (F.tid == 0) __hip_atomic_store(F.ctl + CW_TMO, 0xBADBA0u | (unsigned)(seam), RLX_AGENT); } \
    else { xcd_barrier(bar); } } while (0)
    unsigned char* ws = args.ws;
    F.ctl = (gu32*)(ws + WS_CTL);
    F.x = args.in[0]; F.n1 = args.in[1]; F.wg1 = args.in[2]; F.wu1 = args.in[3]; F.wd1 = args.in[4]; F.nmix = args.in[5]; F.win = args.in[6]; F.lbnd = args.in[7];
    F.hnorm = args.in[8]; F.wout = args.in[9]; F.n2 = args.in[10]; F.wg2 = args.in[11]; F.wu2 = args.in[12]; F.wd2 = args.in[13]; F.nfin = args.in[14]; F.out = args.out;
    F.WGU1 = (bf16*)(ws + WS_WGU1); F.WD1 = (bf16*)(ws + WS_WD1); F.WIN = (bf16*)(ws + WS_WIN); F.WOUT = (bf16*)(ws + WS_WOUT); F.WGU2 = (bf16*)(ws + WS_WGU2); F.WD2 = (bf16*)(ws + WS_WD2);
    F.XN = (bf16*)(ws + WS_XN); F.ACT = (bf16*)(ws + WS_ACT); F.QH = (bf16*)(ws + WS_QH); F.VH = (bf16*)(ws + WS_VH); F.GH = (bf16*)(ws + WS_GH);
    F.MQ = (bf16*)(ws + WS_MQ); F.MK = (bf16*)(ws + WS_MK); F.MV = (bf16*)(ws + WS_MV);
    F.FG = (float*)(ws + WS_F); F.ORAW = (float*)(ws + WS_ORAW); F.KMEAN = (float*)(ws + WS_KMEAN);
    for (int u = F.tid; u < (LDS_BYTES - LDSCTL_OFF) / 4; u += NWAVES * 64) ((LAS unsigned*)(F.lds + LDSCTL_OFF))[u] = 0u;
    __syncthreads();
    XcdBarrier bar; bar.bar = (unsigned*)(F.ctl + CW_BAR); bar.x = 0; bar.st = nullptr;
    if (N_LAUNCHES != PER_PHASE) bar = xcd_barrier_post((unsigned*)(F.ctl + CW_BAR), F.MISC + 8);

    const int lo = args.ph_lo, hi = args.ph_hi;
#define IN(k) (lo <= (k) && (k) < hi)
#define BOTH(k) (IN(k) && IN((k) + 1))

    if (IN(0)) { p0_prologue(F); if (BOTH(0)) GRID_BAR(0); }
    if (IN(1)) {
        pg8::Gemm g{F.XN, F.WGU1, M, NGU, D}; pg8::StaticOrder S; S.init(M, NGU, F.G, (int)blockIdx.x);
        pg8::EpiSwiGLU E{F.ACT, FF};
        pg8::gemm_phase<pg8::EpiSwiGLU, pg8::StaticOrder, true, true>(F.lds + RING_OFF, g, S, E);
        if (BOTH(1)) GRID_BAR(1);
    }
    if (IN(2)) {
        pg8::Gemm g{F.ACT, F.WD1, M, D, FF}; pg8::StaticOrder S; S.init(M, D, F.G, (int)blockIdx.x);
        pg8::EpiResF32 E{F.x, F.out, D, 0.5f};
        pg8::gemm_phase<pg8::EpiResF32, pg8::StaticOrder, true, true>(F.lds + RING_OFF, g, S, E);
        if (BOTH(2)) GRID_BAR(2);
    }
    if (IN(3)) { norm_phase_bf16(F, F.out, F.nmix, F.XN); if (BOTH(3)) GRID_BAR(3); }
    if (IN(4)) {
        pg8::Gemm g{F.XN, F.WIN, M, NIN, D}; pg8::StaticOrder S; S.init(M, NIN, F.G, (int)blockIdx.x);
        pg8::EpiInProj E{F.QH, F.VH, F.GH, F.MQ, F.MK, F.MV, F.FG, F.lbnd};
        pg8::gemm_phase<pg8::EpiInProj, pg8::StaticOrder, true, true>(F.lds + RING_OFF, g, S, E);
        if (BOTH(4)) GRID_BAR(4);
    }
    if (IN(5)) { kmean_phase(F); hgrn_scan_phase(F); if (BOTH(5)) GRID_BAR(5); }
    if (IN(6)) { moba_phase(F); hgrn_post_phase(F); if (BOTH(6)) GRID_BAR(6); }
    if (IN(7)) {
        pg8::Gemm g{F.XN, F.WOUT, M, D, D}; pg8::StaticOrder S; S.init(M, D, F.G, (int)blockIdx.x);
        pg8::EpiResF32 E{F.out, F.out, D, 1.0f};
        pg8::gemm_phase<pg8::EpiResF32, pg8::StaticOrder, true, true>(F.lds + RING_OFF, g, S, E);
        if (BOTH(7)) GRID_BAR(7);
    }
    if (IN(8)) { norm_phase_bf16(F, F.out, F.n2, F.XN); if (BOTH(8)) GRID_BAR(8); }
    if (IN(9)) {
        pg8::Gemm g{F.XN, F.WGU2, M, NGU, D}; pg8::StaticOrder S; S.init(M, NGU, F.G, (int)blockIdx.x);
        pg8::EpiSwiGLU E{F.ACT, FF};
        pg8::gemm_phase<pg8::EpiSwiGLU, pg8::StaticOrder, true, true>(F.lds + RING_OFF, g, S, E);
        if (BOTH(9)) GRID_BAR(9);
    }
    if (IN(10)) {
        pg8::Gemm g{F.ACT, F.WD2, M, D, FF}; pg8::StaticOrder S; S.init(M, D, F.G, (int)blockIdx.x);
        pg8::EpiResF32 E{F.out, F.out, D, 0.5f};
        pg8::gemm_phase<pg8::EpiResF32, pg8::StaticOrder, true, true>(F.lds + RING_OFF, g, S, E);
        if (BOTH(10)) GRID_BAR(10);
    }
    if (IN(11)) {
        const int gw = F.vcu * NWAVES + F.wave, NGW = F.G * NWAVES;
        for (int m = gw; m < M; m += NGW) rms_row_f32(F.out + (size_t)m * D, F.nfin, F.out + (size_t)m * D, F.lane);
    }
#undef IN
#undef BOTH
}

extern "C" void kernel_launch(void* const* d_in, const int* in_sizes, int n_in, void* d_out, int out_size, void* d_ws, size_t ws_size, hipStream_t stream) {
    static int grid = 0;
    if (grid == 0) {
        if (n_in != 15 || in_sizes[0] != M * D || out_size != M * D || ws_size < WS_END) { fprintf(stderr, "kernel_launch: shape/workspace mismatch (n_in %d, in0 %d, out %d, ws %zu); nothing launched\n", n_in, n_in > 0 ? in_sizes[0] : -1, out_size, ws_size); grid = -1; return; }
        int dev = 0, cus = 0, per_cu = 0;
        if (hipGetDevice(&dev) != hipSuccess || hipDeviceGetAttribute(&cus, hipDeviceAttributeMultiprocessorCount, dev) != hipSuccess) { fprintf(stderr, "kernel_launch: device query failed\n"); grid = -1; return; }
        if (hipFuncSetAttribute((const void*)mk_fwd, hipFuncAttributeMaxDynamicSharedMemorySize, LDS_BYTES) != hipSuccess) { fprintf(stderr, "kernel_launch: hipFuncSetAttribute failed\n"); grid = -1; return; }
        if (hipOccupancyMaxActiveBlocksPerMultiprocessor(&per_cu, (const void*)mk_fwd, NWAVES * 64, LDS_BYTES) != hipSuccess || per_cu < 1)
            fprintf(stderr, "kernel_launch: note: occupancy query reports %d workgroups per CU\n", per_cu);
        (void)hipGetLastError();
        grid = cus;
    }
    if (grid < 0) return;
    if (hipMemsetAsync((char*)d_ws + WS_CTL, 0, CTL_ZERO_BYTES, stream) != hipSuccess) { fprintf(stderr, "kernel_launch: hipMemsetAsync failed\n"); return; }
    Args a{};
    for (int i = 0; i < 15; ++i) a.in[i] = (const float*)d_in[i];
    a.out = (float*)d_out; a.ws = (unsigned char*)d_ws;
    for (int li = 0; li < N_LAUNCHES; ++li) {
        a.ph_lo = (N_LAUNCHES == PER_PHASE) ? li : 0; a.ph_hi = (N_LAUNCHES == PER_PHASE) ? li + 1 : PER_PHASE; a.li = li;
        hipLaunchKernelGGL(mk_fwd, dim3(grid), dim3(NWAVES * 64), LDS_BYTES, stream, a);
        const hipError_t le = hipPeekAtLastError();
        if (le != hipSuccess) { fprintf(stderr, "kernel_launch: launch %d failed: %s\n", li, hipGetErrorName(le)); break; }
    }
}
```

```cpp
#include <hip/hip_runtime.h>
#include <cstdio>
#include <cstdint>
namespace pg8 {
#define PG8_LAS __attribute__((address_space(3)))
typedef unsigned short bf16_t;
typedef short bf16x8 __attribute__((ext_vector_type(8)));
typedef float f32x4 __attribute__((ext_vector_type(4)));
typedef unsigned u32x4 __attribute__((ext_vector_type(4)));
constexpr int BM = 256, BK = 64, HALF = 128, HTB = HALF * BK * 2  , STAGE_BYTES = 8 * HTB, NXCD = 8, WGM = 8;

__host__ __device__ __forceinline__ int lds_byte(int r, int c) { const int st = (r >> 4) * 2 + (c >> 5), rr = r & 15, cc = c & 31, ob = rr * 64 + cc * 2; return st * 1024 + (ob ^ (((ob >> 9) & 1) << 5)); }
__host__ __device__ __forceinline__ void stage_rc(int b, int& R, int& C) { const int st = b / 1024, sb = b % 1024, swz = sb ^ (((sb >> 9) & 1) << 5); R = (st >> 1) * 16 + swz / 64; C = (st & 1) * 32 + (swz % 64) / 2; }
__host__ __device__ __forceinline__ int perm32(int rho) { const int n = rho >> 4, i = rho & 15; return 8 * (i >> 2) + 4 * n + (i & 3); }

struct Unit { int pm, pn; };
struct Gemm { const bf16_t* A; const bf16_t* Bt; int M, N, K; };

struct StaticOrder {
    int nM, nN, nwg, G, c;
    __host__ __device__ void init(int M, int N, int G_, int c_) { nM = M / BM; nN = N / BM; nwg = nM * nN; G = G_; c = c_; }
    __host__ __device__ bool next(int i, Unit& u) const {
        const long L = (long)i * G + c; if (L >= nwg) return false;
        int wgid = (int)L; { const int q = nwg / NXCD, r = nwg % NXCD, xcd = wgid % NXCD, off = wgid / NXCD; wgid = (xcd < r ? xcd * (q + 1) : r * (q + 1) + (xcd - r) * q) + off; }
        const int nig = WGM * nN, gid = wgid / nig, fm = gid * WGM, gsz = (nM - fm) < WGM ? (nM - fm) : WGM;
        u.pm = fm + ((wgid % nig) % gsz); u.pn = (wgid % nig) / gsz; return true;
    }
    __device__ __forceinline__ void a_ready(const Unit&) const {}
    __device__ __forceinline__ void done(const Unit&) const {}
};

__device__ __forceinline__ unsigned cvt_pk_bf16(float lo, float hi) { unsigned r; asm volatile("v_cvt_pk_bf16_f32 %0, %1, %2" : "=v"(r) : "v"(lo), "v"(hi)); return r; }
typedef float f32x2 __attribute__((ext_vector_type(2)));

__device__ __forceinline__ float sigmoid_fast(float a) { return __builtin_amdgcn_rcpf(1.0f + __builtin_amdgcn_exp2f(-1.4426950408889634f * a)); }

struct EpiSwiGLU {
    static constexpr bool PERM = true, AFTER_DRAIN = false;
    bf16_t* O; int ldc;
    __device__ __forceinline__ void operator()(const f32x4 (&acc)[2][2][4][2], const Unit& u, int wr, int wc, int fr, int fq) const {
        const int row0 = u.pm * BM + wr * 64 + fr, col0 = u.pn * HALF + wc * 32 + 8 * fq;
#pragma unroll
        for (int ai = 0; ai < 2; ++ai)
#pragma unroll
            for (int m = 0; m < 4; ++m) { bf16_t* rowp = O + (size_t)(row0 + ai * HALF + m * 16) * ldc + col0;
                f32x4 v0, v1;
#pragma unroll
                for (int i = 0; i < 4; ++i) { const float g0 = acc[ai][0][m][0][i], g1 = acc[ai][0][m][1][i];
                    v0[i] = g0 * sigmoid_fast(g0) * acc[ai][1][m][0][i]; v1[i] = g1 * sigmoid_fast(g1) * acc[ai][1][m][1][i]; }
                u32x4 w; w.x = cvt_pk_bf16(v0[0], v0[1]); w.y = cvt_pk_bf16(v0[2], v0[3]); w.z = cvt_pk_bf16(v1[0], v1[1]); w.w = cvt_pk_bf16(v1[2], v1[3]);
                *(u32x4*)rowp = w; }
    }
};

struct EpiResF32 {
    static constexpr bool PERM = false, AFTER_DRAIN = false;
    const float* base; float* out; int ldc; float alpha;
    __device__ __forceinline__ void operator()(const f32x4 (&acc)[2][2][4][2], const Unit& u, int wr, int wc, int fr, int fq) const {
        const int row0 = u.pm * BM + wr * 64 + fr, col0 = u.pn * BM + wc * 32 + 4 * fq;
#pragma unroll
        for (int ai = 0; ai < 2; ++ai)
#pragma unroll
            for (int m = 0; m < 4; ++m) { const size_t off = (size_t)(row0 + ai * HALF + m * 16) * ldc + col0;
                f32x4 bs[2][2];
#pragma unroll
                for (int bj = 0; bj < 2; ++bj)
#pragma unroll
                    for (int n = 0; n < 2; ++n) bs[bj][n] = *(const f32x4*)(base + off + bj * HALF + n * 16);
#pragma unroll
                for (int bj = 0; bj < 2; ++bj)
#pragma unroll
                    for (int n = 0; n < 2; ++n) *(f32x4*)(out + off + bj * HALF + n * 16) = bs[bj][n] + acc[ai][bj][m][n] * alpha;
                asm volatile("" ::: "memory"); }
    }
};

struct EpiInProj {
    static constexpr bool PERM = true, AFTER_DRAIN = false;
    bf16_t* QH; bf16_t* VH; bf16_t* GH; bf16_t* MQ; bf16_t* MK; bf16_t* MV; float* F; const float* lbnd;
    __device__ __forceinline__ void operator()(const f32x4 (&acc)[2][2][4][2], const Unit& u, int wr, int wc, int fr, int fq) const {
        const int seg = u.pn >> 3, cs = (u.pn & 7) * BM + wc * 32 + 8 * fq, row0 = u.pm * BM + wr * 64 + fr;
        if (seg == 1) {
            float lb[2][8];
#pragma unroll
            for (int bj = 0; bj < 2; ++bj)
#pragma unroll
                for (int n = 0; n < 2; ++n) { const f32x4 a = *(const f32x4*)(lbnd + cs + bj * HALF + 4 * n), b = *(const f32x4*)(lbnd + 2048 + cs + bj * HALF + 4 * n);
#pragma unroll
                    for (int i = 0; i < 4; ++i) lb[bj][4 * n + i] = sigmoid_fast(a[i] - b[i]); }
#pragma unroll
            for (int ai = 0; ai < 2; ++ai)
#pragma unroll
                for (int m = 0; m < 4; ++m) { float* rowp = F + (size_t)(row0 + ai * HALF + m * 16) * 2048 + cs;
#pragma unroll
                    for (int bj = 0; bj < 2; ++bj)
#pragma unroll
                        for (int n = 0; n < 2; ++n) { f32x4 o;
#pragma unroll
                            for (int i = 0; i < 4; ++i) { const float l = lb[bj][4 * n + i]; o[i] = l + (1.0f - l) * sigmoid_fast(acc[ai][bj][m][n][i]); }
                            *(f32x4*)(rowp + bj * HALF + 4 * n) = o; } }
        } else {
            bf16_t* base = QH; float sc = 0.08838834764831845f; bool act = true;
            if (seg == 2) { base = VH; sc = 1.f; act = false; }
            else if (seg == 3) { base = GH; sc = 1.f; act = true; }
            else if (seg == 4) { base = MQ; sc = 0.08838834764831845f * 1.4426950408889634f; act = false; }
            else if (seg == 5) { base = MK; sc = 1.f; act = false; }
            else if (seg == 6) { base = MV; sc = 1.f; act = false; }
#pragma unroll
            for (int ai = 0; ai < 2; ++ai)
#pragma unroll
                for (int m = 0; m < 4; ++m) { bf16_t* rowp = base + (size_t)(row0 + ai * HALF + m * 16) * 2048 + cs;
#pragma unroll
                    for (int bj = 0; bj < 2; ++bj) { f32x4 v0 = acc[ai][bj][m][0], v1 = acc[ai][bj][m][1];
                        if (act) {
#pragma unroll
                            for (int i = 0; i < 4; ++i) { v0[i] = v0[i] * sigmoid_fast(v0[i]); v1[i] = v1[i] * sigmoid_fast(v1[i]); } }
                        v0 = v0 * sc; v1 = v1 * sc;
                        u32x4 w; w.x = cvt_pk_bf16(v0[0], v0[1]); w.y = cvt_pk_bf16(v0[2], v0[3]); w.z = cvt_pk_bf16(v1[0], v1[1]); w.w = cvt_pk_bf16(v1[2], v1[3]);
                        *(u32x4*)(rowp + bj * HALF) = w; } }
        }
    }
};

template <class Epi, class Sched, bool ALIGN_EPI = false, bool SP2 = false>
__device__ __forceinline__ void gemm_phase(PG8_LAS unsigned char* lds, const Gemm g, const Sched& S, const Epi& E) {
    const int tid = threadIdx.x, wid = __builtin_amdgcn_readfirstlane(tid >> 6), lane = tid & 63, wr = wid >> 2, wc = wid & 3, fr = lane & 15, fq = lane >> 4;
    const int K = g.K, nt = K / BK;
    unsigned voffA[2], voffB[2];
#pragma unroll
    for (int i = 0; i < 2; ++i) { int R, C; stage_rc(tid * 16 + i * 8192, R, C); const int Rb = Epi::PERM ? ((R & ~31) + perm32(R & 31)) : R;
        voffA[i] = (unsigned)(R * K + C) * 2u; voffB[i] = (unsigned)(Rb * K + C) * 2u; }
    const size_t kstep = (size_t)(BK * 2);
    const size_t hstep = (size_t)HALF * K * 2;
    const size_t tstep = 2 * hstep;
    const unsigned ldsw = (unsigned)wid * 1024u;
    const int aoff = lds_byte(wr * 64 + fr, fq * 8), boff = lds_byte(wc * 32 + fr, fq * 8);
#define PG8_SA(b, h) (((b) * 2 + (h)) * HTB)
#define PG8_SB(b, h) ((4 + (b) * 2 + (h)) * HTB)
#define PG8_STAGE(bufoff, gbase, voff) do { _Pragma("unroll") for (int _i = 0; _i < 2; ++_i) \
        __builtin_amdgcn_global_load_lds((const unsigned*)((const char*)(gbase) + (voff)[_i]), (PG8_LAS unsigned*)(lds + (bufoff) + ldsw + _i * 8192), 16, 0, 0); } while (0)
#define PG8_LDA(dst, b, h) do { _Pragma("unroll") for (int m = 0; m < 4; ++m) _Pragma("unroll") for (int k = 0; k < 2; ++k) dst[m][k] = *(const PG8_LAS bf16x8*)(lds + PG8_SA(b, h) + aoff + m * 2048 + k * 1024); } while (0)
#define PG8_LDB(dst, b, h) do { _Pragma("unroll") for (int n = 0; n < 2; ++n) _Pragma("unroll") for (int k = 0; k < 2; ++k) dst[n][k] = *(const PG8_LAS bf16x8*)(lds + PG8_SB(b, h) + boff + n * 2048 + k * 1024); } while (0)
#define PG8_MMA(ai, bj, At, Bt) do { __builtin_amdgcn_s_setprio(1); _Pragma("unroll") for (int m = 0; m < 4; ++m) _Pragma("unroll") for (int n = 0; n < 2; ++n) _Pragma("unroll") for (int k = 0; k < 2; ++k) \
        acc[ai][bj][m][n] = __builtin_amdgcn_mfma_f32_16x16x32_bf16(Bt[n][k], At[m][k], acc[ai][bj][m][n], 0, 0, 0); __builtin_amdgcn_s_setprio(0); } while (0)
#define PG8_WAIT_V(n) asm volatile("s_waitcnt vmcnt(" #n ")" ::: "memory")
#define PG8_WAIT_L(n) asm volatile("s_waitcnt lgkmcnt(" #n ")" ::: "memory")
#define PG8_BAR __builtin_amdgcn_s_barrier()
#define PG8_SCHED __builtin_amdgcn_sched_barrier(0)
    Unit cur, nxt; int ui = 0;
    if (!S.next(0, cur)) return;
    f32x4 acc[2][2][4][2];
#pragma unroll
    for (int a = 0; a < 2; ++a)
#pragma unroll
        for (int b = 0; b < 2; ++b)
#pragma unroll
            for (int m = 0; m < 4; ++m)
#pragma unroll
                for (int n = 0; n < 2; ++n) acc[a][b][m][n] = (f32x4){0.f, 0.f, 0.f, 0.f};
    bf16x8 At[4][2], B0[2][2], B1[2][2];
    const char* cA = (const char*)g.A + (size_t)cur.pm * tstep; const char* cB = (const char*)g.Bt + (size_t)cur.pn * tstep;
    S.a_ready(cur);
    if constexpr (SP2) {
        PG8_STAGE(PG8_SB(0, 0), cB, voffB); PG8_STAGE(PG8_SB(0, 1), cB + hstep, voffB); PG8_STAGE(PG8_SA(0, 0), cA, voffA); PG8_STAGE(PG8_SA(0, 1), cA + hstep, voffA);
        if (wr == 1) PG8_BAR;
        PG8_WAIT_V(2); PG8_BAR;
        PG8_STAGE(PG8_SB(1, 0), cB + kstep, voffB); PG8_STAGE(PG8_SA(1, 0), cA + kstep, voffA); PG8_STAGE(PG8_SB(1, 1), cB + hstep + kstep, voffB);
        PG8_WAIT_V(6); PG8_BAR;
    } else {
        PG8_STAGE(PG8_SB(0, 0), cB, voffB); PG8_STAGE(PG8_SA(0, 0), cA, voffA); PG8_STAGE(PG8_SB(0, 1), cB + hstep, voffB); PG8_STAGE(PG8_SA(0, 1), cA + hstep, voffA);
        if (wr == 1) PG8_BAR;
        PG8_WAIT_V(4); PG8_BAR;
        PG8_STAGE(PG8_SB(1, 0), cB + kstep, voffB); PG8_STAGE(PG8_SA(1, 0), cA + kstep, voffA); PG8_STAGE(PG8_SB(1, 1), cB + hstep + kstep, voffB);
        PG8_WAIT_V(6); PG8_BAR;
    }
    for (;;) {
        const bool has_next = S.next(ui + 1, nxt);
        const char* nA = has_next ? (const char*)g.A + (size_t)nxt.pm * tstep : cA; const char* nB = has_next ? (const char*)g.Bt + (size_t)nxt.pn * tstep : cB;
        for (int t = 0; t < nt; t += 2) {
            const bool last = (t == nt - 2);
            const char* a1 = cA + (size_t)(t + 1) * kstep;
            const char* a2 = last ? nA : cA + (size_t)(t + 2) * kstep; const char* b2 = last ? nB : cB + (size_t)(t + 2) * kstep;
            const char* a3 = a2 + kstep; const char* b3 = b2 + kstep;
            if (last && has_next) S.a_ready(nxt);
            if constexpr (SP2) {
            PG8_LDB(B0, 0, 0); PG8_LDB(B1, 0, 1); PG8_SCHED; PG8_LDA(At, 0, 0); PG8_STAGE(PG8_SA(1, 1), a1 + hstep, voffA);
            PG8_WAIT_V(8); PG8_WAIT_L(0); PG8_BAR; PG8_MMA(0, 0, At, B0); PG8_MMA(0, 1, At, B1); PG8_BAR; PG8_SCHED;
            PG8_LDA(At, 0, 1); PG8_STAGE(PG8_SB(0, 0), b2, voffB); PG8_STAGE(PG8_SB(0, 1), b2 + hstep, voffB); PG8_STAGE(PG8_SA(0, 0), a2, voffA);
            PG8_WAIT_V(8); PG8_WAIT_L(0); PG8_BAR; PG8_MMA(1, 0, At, B0); PG8_MMA(1, 1, At, B1); PG8_BAR; PG8_SCHED;
            PG8_LDB(B0, 1, 0); PG8_LDB(B1, 1, 1); PG8_SCHED; PG8_LDA(At, 1, 0); PG8_STAGE(PG8_SA(0, 1), a2 + hstep, voffA);
            PG8_WAIT_V(8); PG8_WAIT_L(0); PG8_BAR; PG8_MMA(0, 0, At, B0); PG8_MMA(0, 1, At, B1); PG8_BAR; PG8_SCHED;
            PG8_LDA(At, 1, 1); PG8_STAGE(PG8_SB(1, 0), b3, voffB); PG8_STAGE(PG8_SB(1, 1), b3 + hstep, voffB); PG8_STAGE(PG8_SA(1, 0), a3, voffA);
            PG8_WAIT_V(8); PG8_WAIT_L(0); PG8_BAR; PG8_MMA(1, 0, At, B0); PG8_MMA(1, 1, At, B1); PG8_BAR; PG8_SCHED;
            } else {
            PG8_LDB(B0, 0, 0); PG8_SCHED; PG8_LDA(At, 0, 0); PG8_STAGE(PG8_SA(1, 1), a1 + hstep, voffA);
            PG8_WAIT_L(8); PG8_BAR; PG8_WAIT_L(0); PG8_MMA(0, 0, At, B0); PG8_BAR; PG8_SCHED;
            PG8_LDB(B1, 0, 1); PG8_STAGE(PG8_SB(0, 0), b2, voffB);
            PG8_BAR; PG8_WAIT_L(0); PG8_MMA(0, 1, At, B1); PG8_BAR;
            PG8_LDA(At, 0, 1); PG8_STAGE(PG8_SA(0, 0), a2, voffA);
            PG8_BAR; PG8_WAIT_L(0); PG8_MMA(1, 0, At, B0); PG8_BAR; PG8_SCHED;
            PG8_STAGE(PG8_SB(0, 1), b2 + hstep, voffB);
            PG8_WAIT_V(6); PG8_BAR; PG8_MMA(1, 1, At, B1); PG8_BAR;
            PG8_LDB(B0, 1, 0); PG8_SCHED; PG8_LDA(At, 1, 0); PG8_STAGE(PG8_SA(0, 1), a2 + hstep, voffA);
            PG8_WAIT_L(8); PG8_BAR; PG8_WAIT_L(0); PG8_MMA(0, 0, At, B0); PG8_BAR; PG8_SCHED;
            PG8_LDB(B1, 1, 1); PG8_STAGE(PG8_SB(1, 0), b3, voffB);
            PG8_BAR; PG8_WAIT_L(0); PG8_MMA(0, 1, At, B1); PG8_BAR;
            PG8_LDA(At, 1, 1); PG8_STAGE(PG8_SA(1, 0), a3, voffA);
            PG8_BAR; PG8_WAIT_L(0); PG8_MMA(1, 0, At, B0); PG8_BAR; PG8_SCHED;
            PG8_STAGE(PG8_SB(1, 1), b3 + hstep, voffB);
            PG8_WAIT_V(6); PG8_BAR; PG8_MMA(1, 1, At, B1); PG8_BAR;
            }
        }
        if constexpr (ALIGN_EPI) { if (wr == 0) PG8_BAR; }
        if constexpr (!Epi::AFTER_DRAIN) { E(acc, cur, wr, wc, fr, fq); S.done(cur); }
        if (!has_next) break;
#pragma unroll
        for (int a = 0; a < 2; ++a)
#pragma unroll
            for (int b = 0; b < 2; ++b)
#pragma unroll
                for (int m = 0; m < 4; ++m)
#pragma unroll
                    for (int n = 0; n < 2; ++n) acc[a][b][m][n] = (f32x4){0.f, 0.f, 0.f, 0.f};
        cur = nxt; cA = nA; cB = nB; ++ui;
        if constexpr (ALIGN_EPI) { if (wr == 1) PG8_BAR; }
    }
    PG8_WAIT_V(0);
    if constexpr (!ALIGN_EPI) { if (wr == 0) PG8_BAR; }
    PG8_BAR;
    if constexpr (Epi::AFTER_DRAIN) { E.fused(acc, cur, wr, wc, fr, fq, lds, wid, lane); S.done(cur); }
#undef PG8_SA
#undef PG8_SB
#undef PG8_STAGE
#undef PG8_LDA
#undef PG8_LDB
#undef PG8_MMA
#undef PG8_WAIT_V
#undef PG8_WAIT_L
#undef PG8_BAR
#undef PG8_SCHED
}
}

constexpr int NWAVES = 8;
#ifndef MK_N_LAUNCHES
#define MK_N_LAUNCHES 1
#endif
constexpr int PER_PHASE = 13;
constexpr int N_LAUNCHES = MK_N_LAUNCHES;

constexpr int BATCH = 4, SEQ = 4096, D = 4096, FF = 11008, NGU = 2 * FF, NIN = 14336, HW = 2048, NHEAD = 16, HD = 128;
constexpr int M = BATCH * SEQ;
constexpr float RMS_EPS = 1e-6f;

constexpr size_t MiB = 1u << 20;
constexpr size_t WS_CTL = 0, CTL_ZERO_BYTES = 1 * MiB;
constexpr size_t WS_KMEAN = 1 * MiB;
constexpr size_t WS_WGU1 = 2 * MiB, WS_WD1 = 174 * MiB, WS_WIN = 260 * MiB, WS_WOUT = 372 * MiB, WS_WGU2 = 404 * MiB, WS_WD2 = 576 * MiB;
constexpr size_t WS_XN = 662 * MiB;
constexpr size_t WS_ACT = 790 * MiB;
constexpr size_t WS_QH = WS_ACT, WS_VH = WS_ACT + 64 * MiB, WS_GH = WS_ACT + 128 * MiB, WS_MQ = WS_ACT + 192 * MiB, WS_MK = WS_ACT + 256 * MiB, WS_MV = WS_ACT + 320 * MiB;
constexpr size_t WS_F = 1238 * MiB;
constexpr size_t WS_ORAW = 1366 * MiB;
constexpr size_t WS_KT = 1174 * MiB;
constexpr size_t WS_KTT = 1494 * MiB;
constexpr size_t WS_DD = 1558 * MiB;
constexpr size_t WS_END = 1560 * MiB;
static_assert(WS_WGU1 + (size_t)NGU * D * 2 <= WS_WD1 && WS_WD1 + (size_t)D * FF * 2 <= WS_WIN && WS_WIN + (size_t)NIN * D * 2 <= WS_WOUT && WS_WOUT + (size_t)D * D * 2 <= WS_WGU2 &&
              WS_WGU2 + (size_t)NGU * D * 2 <= WS_WD2 && WS_WD2 + (size_t)D * FF * 2 <= WS_XN && WS_XN + (size_t)M * D * 2 <= WS_ACT && WS_ACT + (size_t)M * FF * 2 <= WS_F &&
              WS_MV + (size_t)M * HW * 2 <= WS_F && WS_F + (size_t)M * HW * 4 <= WS_ORAW && WS_ORAW + (size_t)M * HW * 4 <= WS_KTT && WS_KT + (size_t)M * HW * 2 <= WS_F && WS_KT >= WS_MV + (size_t)M * HW * 2 && WS_KTT + (size_t)M * HW * 2 <= WS_DD && WS_DD + (size_t)M / 64 * HW * 4 <= WS_END, "d_ws map");
constexpr int CW_TMO = 0, CW_CODE = 1;
constexpr int CW_BAR = 4096;

constexpr int RING_OFF = 0, RING_BYTES = 131072;
constexpr int LDSCTL_OFF = RING_BYTES, MISC_OFF = LDSCTL_OFF + 320;
constexpr int LDS_BYTES = 147456;
static_assert(MISC_OFF + 128 <= LDS_BYTES, "LDS map");

#define GAS __attribute__((address_space(1)))
#define LAS __attribute__((address_space(3)))
typedef unsigned short bf16;
typedef unsigned v4u __attribute__((ext_vector_type(4)));
typedef float f32x4 __attribute__((ext_vector_type(4)));
typedef short bf16x8 __attribute__((ext_vector_type(8)));
typedef GAS unsigned gu32;
typedef GAS unsigned long long gu64;
#define RLX_AGENT __ATOMIC_RELAXED, __HIP_MEMORY_SCOPE_AGENT
#define LDS_WAIT() asm volatile("s_waitcnt lgkmcnt(0)" ::: "memory")
#define VM_WAIT() asm volatile("s_waitcnt vmcnt(0)" ::: "memory")
__device__ __forceinline__ unsigned long long rt() { return __builtin_amdgcn_s_memrealtime(); }
__device__ __forceinline__ unsigned f2bf(float f) { unsigned u = __builtin_bit_cast(unsigned, f); return (u + 0x7fffu + ((u >> 16) & 1u)) >> 16; }
__device__ __forceinline__ unsigned pk2(float lo, float hi) { return f2bf(lo) | (f2bf(hi) << 16); }

#define XB_TMO      128
#define XB_XCNT(j)  (256  + 64 * (j))
#define XB_XSUB(j)  (1280 + 64 * (j))
#define XB_XGEN(j)  (2304 + 64 * (j))
#define XB_TOP      3328
#define XB_TOPGEN   3392
#define XCD_BAR_WORDS 3456
#define XB_SPIN_CAP (1u << 18)

__device__ __forceinline__ unsigned xb_ld(unsigned* p)              { return __hip_atomic_load(p, __ATOMIC_RELAXED, __HIP_MEMORY_SCOPE_AGENT); }
__device__ __forceinline__ unsigned xb_add(unsigned* p, unsigned v) { return __hip_atomic_fetch_add(p, v, __ATOMIC_RELAXED, __HIP_MEMORY_SCOPE_AGENT); }
__device__ __forceinline__ unsigned xb_xcc_id() { return (unsigned)__builtin_amdgcn_s_getreg((3 << 11) | 20) & 0xFu; }
#define XB_SPIN(cond, bar) do { unsigned _sp = 0; while (cond) { __builtin_amdgcn_s_sleep(1); \
    if ((++_sp & 255u) == 0u) { if (xb_ld(&(bar)[XB_TMO])) break; if (_sp > XB_SPIN_CAP) { atomicAdd(&(bar)[XB_TMO], 1u); break; } } } } while (0)

struct XcdBarrier {
    unsigned* bar; unsigned x;
    volatile LAS unsigned* st;
};

__device__ __forceinline__ XcdBarrier xcd_barrier_post(unsigned* bar, volatile LAS unsigned* st) {
    XcdBarrier b; b.bar = bar; b.x = xb_xcc_id(); b.st = st;
    if (threadIdx.x == 0) (void)xb_add(&bar[XB_XCNT(b.x)], 1u);
    return b;
}
__device__ __forceinline__ void xcd_barrier_complete(unsigned* bar, unsigned x, unsigned& nloc, unsigned& nx) {
    const unsigned G = gridDim.x * gridDim.y * gridDim.z;
    unsigned sum, cnt, mine, sp = 0u;
    for (;;) {
        sum = 0u; cnt = 0u; mine = 0u;
#pragma unroll
        for (unsigned j = 0; j < 16; ++j) { const unsigned c = xb_ld(&bar[XB_XCNT(j)]); sum += c; cnt += (c > 0u) ? 1u : 0u; mine = (j == x) ? c : mine; }
        if (sum == G) break;
        __builtin_amdgcn_s_sleep(1);
        if ((++sp & 255u) == 0u) { if (xb_ld(&bar[XB_TMO])) break; if (sp > XB_SPIN_CAP) { atomicAdd(&bar[XB_TMO], 1u); break; } }
    }
    nloc = mine > 0u ? mine : 1u; nx = cnt > 0u ? cnt : 1u;
}

__device__ __forceinline__ void xcd_barrier(const XcdBarrier& b) {
    asm volatile("s_waitcnt vmcnt(0)" ::: "memory");
    __syncthreads();
    if (threadIdx.x == 0) {
        unsigned* bar = b.bar;
        __builtin_amdgcn_s_waitcnt(0);
        unsigned nloc = b.st[0], nx = b.st[1];
        if (nloc == 0u) { xcd_barrier_complete(bar, b.x, nloc, nx); b.st[0] = nloc; b.st[1] = nx; }
        const unsigned old = xb_add(&bar[XB_XSUB(b.x)], 1u);
        const unsigned gen = old / nloc;
        if (old + 1u == (gen + 1u) * nloc) {
            __builtin_amdgcn_fence(__ATOMIC_RELEASE, "agent");
            asm volatile("s_waitcnt vmcnt(0)" ::: "memory");
            const unsigned og = xb_add(&bar[XB_TOP], 1u);
            const unsigned tg = og / nx;
            if (og + 1u == (tg + 1u) * nx) xb_add(&bar[XB_TOPGEN], 1u);
            else XB_SPIN(xb_ld(&bar[XB_TOPGEN]) == tg, bar);
            __builtin_amdgcn_fence(__ATOMIC_ACQUIRE, "agent");
            xb_add(&bar[XB_XGEN(b.x)], 1u);
            asm volatile("s_waitcnt vmcnt(0)" ::: "memory");
        } else {
            XB_SPIN(xb_ld(&bar[XB_XGEN(b.x)]) == gen, bar);
            __builtin_amdgcn_fence(__ATOMIC_ACQUIRE, "agent");
            asm volatile("s_waitcnt vmcnt(0)" ::: "memory");
        }
    }
    __syncthreads();
}

typedef float f32x16 __attribute__((ext_vector_type(16)));
typedef short s16x4 __attribute__((ext_vector_type(4)));
typedef unsigned v2u __attribute__((ext_vector_type(2)));
typedef float f32x2 __attribute__((ext_vector_type(2)));
struct Frame {
    LAS unsigned char* lds;
    volatile LAS unsigned* MISC;
    gu32* ctl;
    int tid, lane, wave;
    int vcu, G;
    const float* x; float* out;
    const float *n1, *wg1, *wu1, *wd1, *nmix, *win, *lbnd, *hnorm, *wout, *n2, *wg2, *wu2, *wd2, *nfin;
    bf16 *WGU1, *WD1, *WIN, *WOUT, *WGU2, *WD2;
    bf16 *XN, *ACT, *QH, *VH, *GH, *MQ, *MK, *MV;
    bf16 *KT, *KTT;
    float *FG, *ORAW, *KMEAN, *DD;
};

__device__ __forceinline__ float wave_sum(float v) {
#pragma unroll
    for (int o = 1; o < 64; o <<= 1) v += __shfl_xor(v, o);
    return v;
}
__device__ __forceinline__ float bf_lo(unsigned w) { return __builtin_bit_cast(float, w << 16); }
__device__ __forceinline__ float bf_hi(unsigned w) { return __builtin_bit_cast(float, w & 0xffff0000u); }

__device__ __forceinline__ void p0_transpose_item(const float* W, int K, int N, bf16* WT, int mode, LAS float* scr, int item, int lane) {
    const int nblk = N / 32, kb = item / nblk, nb = item % nblk, k0 = 64 * kb, n0 = 32 * nb;
    const int rbase = (mode == 0) ? n0 : (256 * (n0 >> 7) + (n0 & 127) + (mode == 2 ? 128 : 0));
#pragma unroll 8
    for (int i = 0; i < 32; ++i) { const int kk = 2 * i + (lane >> 5); scr[kk * 33 + (lane & 31)] = W[(size_t)(k0 + kk) * N + n0 + (lane & 31)]; }
    LDS_WAIT(); asm volatile("" ::: "memory");
    const int c = lane & 7;
#pragma unroll
    for (int j = 0; j < 4; ++j) { const int n = (lane >> 3) + 8 * j; const LAS float* s = scr + (8 * c) * 33 + n;
        v4u o; o.x = pk2(s[0 * 33], s[1 * 33]); o.y = pk2(s[2 * 33], s[3 * 33]); o.z = pk2(s[4 * 33], s[5 * 33]); o.w = pk2(s[6 * 33], s[7 * 33]);
        *(GAS v4u*)(WT + (size_t)(rbase + n) * K + k0 + 8 * c) = o; }
    LDS_WAIT(); asm volatile("" ::: "memory");
}
__device__ __forceinline__ void rms_row_bf16(const float* xrow, const float* g, bf16* orow, int lane) {
    const GAS f32x4* xr = (const GAS f32x4*)xrow + lane; const GAS f32x4* gr = (const GAS f32x4*)g + lane;
    f32x4 v[16]; float s = 0.f;
#pragma unroll
    for (int j = 0; j < 16; ++j) { v[j] = xr[64 * j]; s += (v[j].x * v[j].x + v[j].y * v[j].y) + (v[j].z * v[j].z + v[j].w * v[j].w); }
    const float r = 1.f / sqrtf(wave_sum(s) * (1.f / D) + RMS_EPS);
    GAS v2u* o8 = (GAS v2u*)orow + lane;
#pragma unroll
    for (int j = 0; j < 16; ++j) { const f32x4 gv = gr[64 * j]; v2u w; w.x = pk2(v[j].x * r * gv.x, v[j].y * r * gv.y); w.y = pk2(v[j].z * r * gv.z, v[j].w * r * gv.w); o8[64 * j] = w; }
}
__device__ __forceinline__ void rms_row_f32(const float* xrow, const float* g, float* orow, int lane) {
    const GAS f32x4* xr = (const GAS f32x4*)xrow + lane; const GAS f32x4* gr = (const GAS f32x4*)g + lane;
    f32x4 v[16]; float s = 0.f;
#pragma unroll
    for (int j = 0; j < 16; ++j) { v[j] = xr[64 * j]; s += (v[j].x * v[j].x + v[j].y * v[j].y) + (v[j].z * v[j].z + v[j].w * v[j].w); }
    const float r = 1.f / sqrtf(wave_sum(s) * (1.f / D) + RMS_EPS);
    GAS f32x4* o = (GAS f32x4*)orow + lane;
#pragma unroll
    for (int j = 0; j < 16; ++j) { const f32x4 gv = gr[64 * j]; o[64 * j] = (v[j] * r) * gv; }
}
__device__ __forceinline__ void norm_phase_bf16(Frame& F, const float* src, const float* g, bf16* dst) {
    const int gw = F.vcu * NWAVES + F.wave, NGW = F.G * NWAVES;
    for (int m = gw; m < M; m += NGW) rms_row_bf16(src + (size_t)m * D, g, dst + (size_t)m * D, F.lane);
}
__device__ __forceinline__ void p0_prologue(Frame& F) {
    LAS float* scr = (LAS float*)(F.lds + RING_OFF + F.wave * 16384);
    const int gw = F.vcu * NWAVES + F.wave, NGW = F.G * NWAVES;
    constexpr int I_GU = (D / 64) * (FF / 32), I_DN = (FF / 64) * (D / 32), I_IN = (D / 64) * (NIN / 32), I_OUT = (D / 64) * (D / 32);
    constexpr int NITEMS = 4 * I_GU + 2 * I_DN + I_IN + I_OUT;
    for (int it = gw; it < NITEMS; it += NGW) {
        int r = it;
        if (r < I_GU) { p0_transpose_item(F.wg1, D, FF, F.WGU1, 1, scr, r, F.lane); continue; } r -= I_GU;
        if (r < I_GU) { p0_transpose_item(F.wu1, D, FF, F.WGU1, 2, scr, r, F.lane); continue; } r -= I_GU;
        if (r < I_DN) { p0_transpose_item(F.wd1, FF, D, F.WD1, 0, scr, r, F.lane); continue; } r -= I_DN;
        if (r < I_IN) { p0_transpose_item(F.win, D, NIN, F.WIN, 0, scr, r, F.lane); continue; } r -= I_IN;
        if (r < I_OUT) { p0_transpose_item(F.wout, D, D, F.WOUT, 0, scr, r, F.lane); continue; } r -= I_OUT;
        if (r < I_GU) { p0_transpose_item(F.wg2, D, FF, F.WGU2, 1, scr, r, F.lane); continue; } r -= I_GU;
        if (r < I_GU) { p0_transpose_item(F.wu2, D, FF, F.WGU2, 2, scr, r, F.lane); continue; } r -= I_GU;
        p0_transpose_item(F.wd2, FF, D, F.WD2, 0, scr, r, F.lane);
    }
    norm_phase_bf16(F, F.x, F.n1, F.XN);
}

__device__ __forceinline__ void kmean_phase(Frame& F) {
    const int gw = F.vcu * NWAVES + F.wave, NGW = F.G * NWAVES, rg = F.lane >> 4, c8 = F.lane & 15;
    for (int item = gw; item < BATCH * 16 * NHEAD; item += NGW) {
        const int b = item >> 8, n = (item >> 4) & 15, h = item & 15;
        const bf16* base = F.MK + ((size_t)(b * SEQ + n * 256 + rg)) * HW + h * HD + 8 * c8;
        float s[8];
#pragma unroll
        for (int k = 0; k < 8; ++k) s[k] = 0.f;
#pragma unroll 8
        for (int i = 0; i < 64; ++i) { const v4u w = *(const GAS v4u*)(base + (size_t)(4 * i) * HW);
            s[0] += bf_lo(w.x); s[1] += bf_hi(w.x); s[2] += bf_lo(w.y); s[3] += bf_hi(w.y); s[4] += bf_lo(w.z); s[5] += bf_hi(w.z); s[6] += bf_lo(w.w); s[7] += bf_hi(w.w); }
#pragma unroll
        for (int k = 0; k < 8; ++k) { s[k] += __shfl_xor(s[k], 16); s[k] += __shfl_xor(s[k], 32); s[k] *= (1.f / 256.f); }
        if (F.lane < 16) { GAS f32x4* o = (GAS f32x4*)(F.KMEAN + ((size_t)((b * 16 + h) * 16 + n)) * HD + 8 * c8);
            o[0] = (f32x4){s[0], s[1], s[2], s[3]}; o[1] = (f32x4){s[4], s[5], s[6], s[7]}; }
    }
}
__device__ __forceinline__ void hgrn_post_phase(Frame& F) {
    const int gw = F.vcu * NWAVES + F.wave, NGW = F.G * NWAVES, lane = F.lane;
    const f32x4 gn = *(const GAS f32x4*)(F.hnorm + ((4 * lane) & 127));
    for (int m = gw; m < M; m += NGW) {
        const GAS f32x4* orow = (const GAS f32x4*)(F.ORAW + (size_t)m * HW) + lane; const GAS v2u* grow = (const GAS v2u*)(F.GH + (size_t)m * HW) + lane;
        GAS v2u* dst = (GAS v2u*)(F.XN + (size_t)m * D) + lane;
        f32x4 v[8]; v2u gw2[8];
#pragma unroll
        for (int j = 0; j < 8; ++j) { v[j] = orow[64 * j]; gw2[j] = grow[64 * j]; }
#pragma unroll
        for (int j = 0; j < 8; ++j) { float s = (v[j].x * v[j].x + v[j].y * v[j].y) + (v[j].z * v[j].z + v[j].w * v[j].w);
#pragma unroll
            for (int o = 1; o < 32; o <<= 1) s += __shfl_xor(s, o);
            const float r = 1.f / sqrtf(s * (1.f / HD) + RMS_EPS);
            v2u w; w.x = pk2((v[j].x * r) * gn.x * bf_lo(gw2[j].x), (v[j].y * r) * gn.y * bf_hi(gw2[j].x)); w.y = pk2((v[j].z * r) * gn.z * bf_lo(gw2[j].y), (v[j].w * r) * gn.w * bf_hi(gw2[j].y));
            dst[64 * j] = w; }
    }
}


__device__ __forceinline__ void hgrn_prepass_phase(Frame& F) {
    const int nthr = F.G * NWAVES * 64;
    for (int item = F.vcu * (NWAVES * 64) + F.tid; item < BATCH * 64 * 1024; item += nthr) {
        const int cp = item & 1023, bc = item >> 10, c = bc & 63, b = bc >> 6, col = 2 * cp, h = col >> 7, k = col & 127;
        const size_t row0 = (size_t)b * SEQ + (size_t)c * 64;
        const GAS float* fp = (const GAS float*)(F.FG + row0 * HW + col); GAS bf16* qp = (GAS bf16*)(F.QH + row0 * HW + col); GAS bf16* kp = (GAS bf16*)(F.KT + row0 * HW + col);
        float cum0 = 0.f, cum1 = 0.f; unsigned kt0[32], kt1[32];
#pragma unroll
        for (int t2 = 0; t2 < 32; ++t2) {
            float ka[2], kb[2];
#pragma unroll
            for (int u = 0; u < 2; ++u) { const int t = 2 * t2 + u;
                const f32x2 f = *(const GAS f32x2*)(fp + (size_t)t * HW); const unsigned qw = *(const GAS unsigned*)(qp + (size_t)t * HW);
                cum0 += __builtin_amdgcn_logf(f.x); cum1 += __builtin_amdgcn_logf(f.y);
                const float q0 = bf_lo(qw) * __builtin_amdgcn_exp2f(cum0), q1 = bf_hi(qw) * __builtin_amdgcn_exp2f(cum1);
                ka[u] = (1.f - f.x) * __builtin_amdgcn_exp2f(fminf(-cum0, 100.f)); kb[u] = (1.f - f.y) * __builtin_amdgcn_exp2f(fminf(-cum1, 100.f));
                *(GAS unsigned*)(qp + (size_t)t * HW) = pk2(q0, q1); *(GAS unsigned*)(kp + (size_t)t * HW) = pk2(ka[u], kb[u]); }
            kt0[t2] = pk2(ka[0], ka[1]); kt1[t2] = pk2(kb[0], kb[1]);
            if ((t2 & 3) == 3) asm volatile("" ::: "memory");
        }
        GAS v4u* dst = (GAS v4u*)(F.KTT + ((((size_t)(b * NHEAD + h) * 64 + c) * 128 + k) * 64));
#pragma unroll
        for (int j = 0; j < 8; ++j) { dst[j] = (v4u){kt0[4 * j], kt0[4 * j + 1], kt0[4 * j + 2], kt0[4 * j + 3]}; dst[8 + j] = (v4u){kt1[4 * j], kt1[4 * j + 1], kt1[4 * j + 2], kt1[4 * j + 3]}; }
        *(GAS f32x2*)(F.DD + ((size_t)(b * NHEAD + h) * 64 + c) * 128 + k) = (f32x2){__builtin_amdgcn_exp2f(cum0), __builtin_amdgcn_exp2f(cum1)};
    }
}
namespace hg2 {
constexpr int PQ = 288, PKT = 160, PV = 160, PP = 160, PS = 288;
constexpr int Q_OFF = 0, K_OFF = Q_OFF + 2 * 64 * PQ, KT_OFF = K_OFF + 64 * PQ, V_OFF = KT_OFF + 128 * PKT, P_OFF = V_OFF + 2 * 32 * PV, S_OFF = P_OFF + 64 * PP, LDS_END = S_OFF + 2 * 32 * PS;
static_assert(LDS_END <= RING_BYTES, "hgrn scan LDS");
#define HFRAG(base, pitch, row, q, ks) (*(const LAS bf16x8*)((base) + (row) * (pitch) + (q) * 16 + (ks) * 64))
__device__ __forceinline__ void scan_unit(Frame& F, int bh, int vq) {
    int tid = threadIdx.x; asm volatile("" : "+v"(tid));
    const int w = __builtin_amdgcn_readfirstlane(tid >> 6), lane = tid & 63, lr = lane & 15, lq = lane >> 4;
    const int b = bh >> 4, h = bh & 15; const size_t row0 = (size_t)b * SEQ;
    LAS unsigned char* L = F.lds + RING_OFF;
    const bf16* Qg = F.QH + row0 * HW + h * HD; const bf16* Kg = F.KT + row0 * HW + h * HD; const bf16* Vg = F.VH + row0 * HW + h * HD + vq * 32;
    const bf16* KTg = F.KTT + (size_t)bh * 64 * 128 * 64; const float* Dg = F.DD + (size_t)bh * 64 * 128 + 16 * w + 4 * lq;
    float* Og = F.ORAW + row0 * HW + h * HD + vq * 32;
    v4u sq[2], sk[2], skt[2], sv; f32x4 sd;
#define HS_LOAD(c) do { _Pragma("unroll") for (int i_ = 0; i_ < 2; ++i_) { const int idx_ = tid + 512 * i_; \
            sq[i_] = *(const GAS v4u*)(Qg + (size_t)((c) * 64 + (idx_ >> 4)) * HW + (idx_ & 15) * 8); sk[i_] = *(const GAS v4u*)(Kg + (size_t)((c) * 64 + (idx_ >> 4)) * HW + (idx_ & 15) * 8); \
            skt[i_] = *(const GAS v4u*)(KTg + ((size_t)(c) * 128 + (idx_ >> 3)) * 64 + (idx_ & 7) * 8); } \
        if (tid < 256) sv = *(const GAS v4u*)(Vg + (size_t)((c) * 64 + (tid >> 2)) * HW + (tid & 3) * 8); \
        sd = *(const GAS f32x4*)(Dg + (size_t)(c) * 128); } while (0)
#define HS_WRITE(bf) do { _Pragma("unroll") for (int i_ = 0; i_ < 2; ++i_) { const int idx_ = tid + 512 * i_; \
            *(LAS v4u*)(L + Q_OFF + (bf) * 64 * PQ + (idx_ >> 4) * PQ + (idx_ & 15) * 16) = sq[i_]; *(LAS v4u*)(L + K_OFF + (idx_ >> 4) * PQ + (idx_ & 15) * 16) = sk[i_]; \
            *(LAS v4u*)(L + KT_OFF + (idx_ >> 3) * PKT + (idx_ & 7) * 16) = skt[i_]; } \
        if (tid < 256) { LAS unsigned short* vt_ = (LAS unsigned short*)(L + V_OFF + (bf) * 32 * PV + ((tid & 3) * 8) * PV + (tid >> 2) * 2); \
            vt_[0 * (PV / 2)] = (unsigned short)sv.x; vt_[1 * (PV / 2)] = (unsigned short)(sv.x >> 16); vt_[2 * (PV / 2)] = (unsigned short)sv.y; vt_[3 * (PV / 2)] = (unsigned short)(sv.y >> 16); \
            vt_[4 * (PV / 2)] = (unsigned short)sv.z; vt_[5 * (PV / 2)] = (unsigned short)(sv.z >> 16); vt_[6 * (PV / 2)] = (unsigned short)sv.w; vt_[7 * (PV / 2)] = (unsigned short)(sv.w >> 16); } } while (0)
    f32x4 st0 = {0.f, 0.f, 0.f, 0.f}, st1 = {0.f, 0.f, 0.f, 0.f};
    HS_LOAD(0);
    for (int i = tid; i < 32 * PS / 4; i += NWAVES * 64) ((LAS unsigned*)(L + S_OFF))[i] = 0u;
    VM_WAIT(); HS_WRITE(0); f32x4 dcur = sd; LDS_WAIT(); __syncthreads();
    const int tt = w & 3, sh = w >> 2;
    for (int c = 0; c < SEQ / 64; ++c) {
        const int bf = c & 1;
        if (c + 1 < SEQ / 64) HS_LOAD(c + 1);
        const LAS unsigned char* Qb = L + Q_OFF + bf * 64 * PQ; const LAS unsigned char* Kb = L + K_OFF; const LAS unsigned char* KTb = L + KT_OFF; const LAS unsigned char* Vb = L + V_OFF + bf * 32 * PV;
        { bf16x8 qf[4];
#pragma unroll
          for (int ks = 0; ks < 4; ++ks) qf[ks] = HFRAG(Qb, PQ, 16 * tt + lr, lq, ks);
#pragma unroll
          for (int i = 0; i < 2; ++i) { const int stile = 2 * sh + i; f32x4 a = {0.f, 0.f, 0.f, 0.f};
              if (stile <= tt) {
#pragma unroll
                  for (int ks = 0; ks < 4; ++ks) a = __builtin_amdgcn_mfma_f32_16x16x32_bf16(HFRAG(Kb, PQ, 16 * stile + lr, lq, ks), qf[ks], a, 0, 0, 0);
                  if (stile == tt) {
#pragma unroll
                      for (int e = 0; e < 4; ++e) if (4 * lq + e > lr) a[e] = 0.f; } }
              v2u pw; pw.x = pk2(a[0], a[1]); pw.y = pk2(a[2], a[3]);
              *(LAS v2u*)(L + P_OFF + (16 * tt + lr) * PP + (16 * stile + 4 * lq) * 2) = pw; } }
        { bf16x8 kf[2];
#pragma unroll
          for (int ks = 0; ks < 2; ++ks) kf[ks] = HFRAG(KTb, PKT, 16 * w + lr, lq, ks);
#pragma unroll
          for (int ks = 0; ks < 2; ++ks) { st0 = __builtin_amdgcn_mfma_f32_16x16x32_bf16(kf[ks], HFRAG(Vb, PV, lr, lq, ks), st0, 0, 0, 0);
                                           st1 = __builtin_amdgcn_mfma_f32_16x16x32_bf16(kf[ks], HFRAG(Vb, PV, 16 + lr, lq, ks), st1, 0, 0, 0); }
          st0 = st0 * dcur; st1 = st1 * dcur;
          LAS unsigned char* Sn = L + S_OFF + (bf ^ 1) * 32 * PS + (16 * w + 4 * lq) * 2;
          v2u s0; s0.x = pk2(st0[0], st0[1]); s0.y = pk2(st0[2], st0[3]); *(LAS v2u*)(Sn + lr * PS) = s0;
          v2u s1; s1.x = pk2(st1[0], st1[1]); s1.y = pk2(st1[2], st1[3]); *(LAS v2u*)(Sn + (16 + lr) * PS) = s1; }
        LDS_WAIT(); __syncthreads();
        { f32x4 o = {0.f, 0.f, 0.f, 0.f}; const LAS unsigned char* Sp = L + S_OFF + bf * 32 * PS;
#pragma unroll
          for (int ks = 0; ks < 2; ++ks) o = __builtin_amdgcn_mfma_f32_16x16x32_bf16(HFRAG(Vb, PV, 16 * sh + lr, lq, ks), HFRAG(L + P_OFF, PP, 16 * tt + lr, lq, ks), o, 0, 0, 0);
#pragma unroll
          for (int ks = 0; ks < 4; ++ks) o = __builtin_amdgcn_mfma_f32_16x16x32_bf16(HFRAG(Sp, PS, 16 * sh + lr, lq, ks), HFRAG(Qb, PQ, 16 * tt + lr, lq, ks), o, 0, 0, 0);
          *(GAS f32x4*)(Og + (size_t)(c * 64 + 16 * tt + lr) * HW + 16 * sh + 4 * lq) = o; }
        if (c + 1 < SEQ / 64) { VM_WAIT(); HS_WRITE(bf ^ 1); dcur = sd; }
        LDS_WAIT(); __syncthreads();
    }
#undef HS_LOAD
#undef HS_WRITE
}
#undef HFRAG
}
__device__ __forceinline__ void hgrn_scan2_phase(Frame& F) {
    for (int unit = F.vcu; unit < BATCH * NHEAD * 4; unit += F.G) hg2::scan_unit(F, unit >> 2, unit & 3);
}


namespace moba {
#define KSWZ(row, colB) ((row) * 256 + ((colB) ^ (((row) & 7) << 4)))
#define SBAR() __builtin_amdgcn_sched_barrier(0)
constexpr int SHM_K = 16384, SHM_V = 16384;
constexpr int V_OFF = 0, K_OFF = 2 * SHM_V, WS_OFF = K_OFF + 2 * SHM_K, G_OFF = WS_OFF + NWAVES * 256, LDS_END = G_OFF + 32 * 256;
static_assert(LDS_END <= RING_BYTES, "moba LDS");
__device__ __forceinline__ int v_st(int k, int c) { const int kk = (k & ~0xC) | ((k & 4) << 1) | ((k & 8) >> 1); return ((kk >> 3) * 4 + (c >> 5)) * 512 + ((kk & 7) * 32 + (c & 31)) * 2; }
__device__ __forceinline__ int v_rd_base(int lane) { return ((lane & 3) << 3) | (((lane >> 2) & 3) << 6) | (((lane >> 4) & 1) << 5) | (((lane >> 5) & 1) << 8); }
constexpr int v_rd_off(int d0, int ks, int half) { return d0 * 512 + ks * 4096 + half * 2048; }
__device__ __forceinline__ int crow(int r, int hi) { return (r & 3) + 8 * (r >> 2) + 4 * hi; }
__device__ __forceinline__ unsigned cvtpk(float lo, float hi) { unsigned r; asm volatile("v_cvt_pk_bf16_f32 %0, %1, %2" : "=v"(r) : "v"(lo), "v"(hi)); return r; }

template <int KB>
__device__ __forceinline__ void qkt(f32x16& p0, f32x16& p1, const LAS unsigned char* K_lds, int r32, int hi, const bf16x8* qr) {
    const LAS unsigned char* kb[4];
#pragma unroll
    for (int dd = 0; dd < 4; ++dd) kb[dd] = K_lds + KB * SHM_K + KSWZ(r32, (dd * 16 + hi * 8) * 2);
#pragma unroll
    for (int d0 = 0; d0 < 8; ++d0) { const LAS unsigned char* a = kb[d0 & 3] + (d0 >> 2) * 128;
        const bf16x8 b0 = *(const LAS bf16x8*)a;
        const bf16x8 b1 = *(const LAS bf16x8*)(a + 32 * 256);
        p0 = __builtin_amdgcn_mfma_f32_32x32x16_bf16(b0, qr[d0], p0, 0, 0, 0);
        p1 = __builtin_amdgcn_mfma_f32_32x32x16_bf16(b1, qr[d0], p1, 0, 0, 0);
        if (d0 & 1) SBAR(); }
}
template <int VB>
__device__ __forceinline__ void pv_tile(f32x16* o, int vb0, bf16x8 pa0, bf16x8 pa1, bf16x8 pa2, bf16x8 pa3) {
#define TRRD(dst, off) asm volatile("ds_read_b64_tr_b16 %0, %1 offset:%2" : "=&v"(dst) : "v"(vb0), "i"(off) : "memory")
#define PV_D0(d0) do { s16x4 l0, l1, l2, l3, h0, h1, h2, h3; constexpr int b_ = VB * SHM_V + v_rd_off(d0, 0, 0); \
        TRRD(l0, b_); TRRD(h0, b_ + 2048); TRRD(l1, b_ + 4096); TRRD(h1, b_ + 6144); TRRD(l2, b_ + 8192); TRRD(h2, b_ + 10240); TRRD(l3, b_ + 12288); TRRD(h3, b_ + 14336); \
        asm volatile("s_waitcnt lgkmcnt(0)" ::: "memory"); SBAR(); \
        o[d0] = __builtin_amdgcn_mfma_f32_32x32x16_bf16(pa0, (bf16x8){l0[0], l0[1], l0[2], l0[3], h0[0], h0[1], h0[2], h0[3]}, o[d0], 0, 0, 0);   \
        o[d0] = __builtin_amdgcn_mfma_f32_32x32x16_bf16(pa1, (bf16x8){l1[0], l1[1], l1[2], l1[3], h1[0], h1[1], h1[2], h1[3]}, o[d0], 0, 0, 0);   \
        o[d0] = __builtin_amdgcn_mfma_f32_32x32x16_bf16(pa2, (bf16x8){l2[0], l2[1], l2[2], l2[3], h2[0], h2[1], h2[2], h2[3]}, o[d0], 0, 0, 0);   \
        o[d0] = __builtin_amdgcn_mfma_f32_32x32x16_bf16(pa3, (bf16x8){l3[0], l3[1], l3[2], l3[3], h3[0], h3[1], h3[2], h3[3]}, o[d0], 0, 0, 0); } while (0)
    PV_D0(0); PV_D0(1); PV_D0(2); PV_D0(3);
#undef PV_D0
#undef TRRD
}

__device__ __forceinline__ void unit(LAS unsigned char* lds, const bf16* MQ, const bf16* MK, const bf16* MV, const float* KMEAN, bf16* MIX, int b, int h, int j) {
    int tid = threadIdx.x; asm volatile("" : "+v"(tid));
    const int wid = __builtin_amdgcn_readfirstlane(tid >> 6), lane = tid & 63, r32 = lane & 31, hi = lane >> 5;
    LAS unsigned char* V_lds = lds + V_OFF; LAS unsigned char* K_lds = lds + K_OFF; LAS unsigned char* G_lds = lds + G_OFF;
    LAS float* wsx = (LAS float*)(lds + WS_OFF) + wid * 64; LAS float* li_l = wsx; LAS float* al_l = wsx + 32;
    const int sr = tid >> 4, sc = (tid & 15) * 8, vst0 = v_st(sr, sc), vst1 = v_st(32 + sr, sc), kws = KSWZ(sr, sc * 2);
    const int vb0 = (int)(uintptr_t)V_lds + v_rd_base(lane);
    const size_t rowb = (size_t)b * SEQ;
    const bf16* Kh = MK + rowb * HW + h * HD + sc; const bf16* Vh = MV + rowb * HW + h * HD + sc;
    const float slope2 = 1.4426950408889634f * __builtin_amdgcn_exp2f(-0.5f * (float)(h + 1));
    const int NT = 4 * (j + 1);
    bf16x8 st_k0, st_k1, st_v0, st_v1;
#define TLOAD(t) do { const size_t r_ = (size_t)((t) * 64 + sr) * HW; st_k0 = *(const GAS bf16x8*)(Kh + r_); st_k1 = *(const GAS bf16x8*)(Kh + r_ + (size_t)32 * HW); \
                      st_v0 = *(const GAS bf16x8*)(Vh + r_); st_v1 = *(const GAS bf16x8*)(Vh + r_ + (size_t)32 * HW); } while (0)
#define TWRITE(bf) do { *(LAS bf16x8*)(K_lds + (bf) * SHM_K + kws) = st_k0; *(LAS bf16x8*)(K_lds + (bf) * SHM_K + kws + 32 * 256) = st_k1; \
                        *(LAS bf16x8*)(V_lds + (bf) * SHM_V + vst0) = st_v0; *(LAS bf16x8*)(V_lds + (bf) * SHM_V + vst1) = st_v1; } while (0)
    bf16x8 qr[8];
    { const bf16* qrow = MQ + (rowb + (size_t)(j * 256 + wid * 32 + r32)) * HW + h * HD + hi * 8;
#pragma unroll
      for (int d0 = 0; d0 < 8; ++d0) qr[d0] = *(const GAS bf16x8*)(qrow + d0 * 16); }
    { const int n = tid >> 5, d4 = (tid & 31) * 4; const f32x4 km = *(const GAS f32x4*)(KMEAN + ((size_t)((b * NHEAD + h) * 16 + n)) * HD + d4);
      const unsigned h0 = f2bf(km.x), h1 = f2bf(km.y), h2 = f2bf(km.z), h3 = f2bf(km.w);
      const float l0 = km.x - __builtin_bit_cast(float, h0 << 16), l1 = km.y - __builtin_bit_cast(float, h1 << 16), l2 = km.z - __builtin_bit_cast(float, h2 << 16), l3 = km.w - __builtin_bit_cast(float, h3 << 16);
      v2u whi, wlo; whi.x = h0 | (h1 << 16); whi.y = h2 | (h3 << 16); wlo.x = pk2(l0, l1); wlo.y = pk2(l2, l3);
      *(LAS v2u*)(G_lds + KSWZ(n, d4 * 2)) = whi; *(LAS v2u*)(G_lds + KSWZ(16 + n, d4 * 2)) = wlo; }
    TLOAD(0); VM_WAIT(); TWRITE(0); LDS_WAIT(); __syncthreads();
    unsigned sel = 0u;
    if (j > 0) {
        f32x16 gp = {};
#pragma unroll
        for (int d0 = 0; d0 < 8; ++d0) { const bf16x8 a = *(const LAS bf16x8*)(G_lds + KSWZ(r32, (d0 * 16 + hi * 8) * 2)); gp = __builtin_amdgcn_mfma_f32_32x32x16_bf16(a, qr[d0], gp, 0, 0, 0); }
        float gm[8], go[8]; int nm[8];
        const float NEG = -__builtin_inff(); const bool hi1 = (hi != 0);
#pragma unroll
        for (int r = 0; r < 8; ++r) { nm[r] = (r & 3) + 8 * (r >> 2) + 4 * hi;
            const float gv = gp[r] + gp[r + 8]; gm[r] = (nm[r] < j) ? gv : NEG; }
#pragma unroll
        for (int r = 0; r < 8; ++r) go[r] = __shfl_xor(gm[r], 32);
        unsigned mine = 0u;
#pragma unroll
        for (int r = 0; r < 8; ++r) { int rank = 0;
#pragma unroll
            for (int q = 0; q < 8; ++q) {
                if (q != r) rank += (gm[q] > gm[r] || (gm[q] == gm[r] && q < r)) ? 1 : 0;
                const bool lower = ((q >> 2) < (r >> 2)) || (((q >> 2) == (r >> 2)) && hi1);
                rank += (go[q] > gm[r] || (go[q] == gm[r] && lower)) ? 1 : 0; }
            if (nm[r] < j && rank < 3) mine |= 1u << nm[r]; }
        sel = mine | (unsigned)__shfl_xor((int)mine, 32);
    }
    const float sl1 = slope2, sl2 = 2.f * slope2, sl3 = 3.f * slope2, sl8 = 8.f * slope2, slh = slope2 * (float)(4 * hi);
    const int tq = wid * 32 + r32;
    float m_reg = -1e30f, l_reg = 0.f; f32x16 o[4] = {};
    f32x16 p0, p1; bf16x8 pa0, pa1, pa2, pa3;
    const float NEGI = -__builtin_inff();
#define RESC(a) do { if (__any((a) < 1.f)) { if (hi == 0) al_l[r32] = (a); asm volatile("s_waitcnt lgkmcnt(0)" ::: "memory");              \
                     _Pragma("unroll") for (int d_ = 0; d_ < 4; ++d_) _Pragma("unroll") for (int r = 0; r < 16; ++r) o[d_][r] *= al_l[crow(r, hi)]; } } while (0)
#define PK4(P, B_, OUT) do { unsigned a0 = cvtpk(P[B_+0], P[B_+1]), a1 = cvtpk(P[B_+2], P[B_+3]);                          \
        unsigned b0 = cvtpk(P[B_+4], P[B_+5]), b1 = cvtpk(P[B_+6], P[B_+7]);                                             \
        auto r0 = __builtin_amdgcn_permlane32_swap(a0, b0, false, false); auto r1 = __builtin_amdgcn_permlane32_swap(a1, b1, false, false); \
        v4u w = {r0[0], r1[0], r0[1], r1[1]}; OUT = *reinterpret_cast<bf16x8*>(&w); } while (0)
#define TILE_STEP(t, KB) do { const int n_ = (t) >> 2, tt_ = (t) & 3; \
        if ((t) + 1 < NT) TLOAD((t) + 1); \
        const bool own_ = (n_ == j); \
        const bool act_ = !(own_ && 64 * tt_ > wid * 32 + 31);             \
        if (act_) { \
            const float bi_ = slope2 * (float)(256 * (n_ - j) + 64 * tt_) + slh; \
            _Pragma("unroll") for (int k_ = 0; k_ < 8; ++k_) { const float bk_ = bi_ + sl8 * (float)k_; \
                if (k_ < 4) { p0[4 * k_] = bk_; p0[4 * k_ + 1] = bk_ + sl1; p0[4 * k_ + 2] = bk_ + sl2; p0[4 * k_ + 3] = bk_ + sl3; } \
                else { p1[4 * k_ - 16] = bk_; p1[4 * k_ - 15] = bk_ + sl1; p1[4 * k_ - 14] = bk_ + sl2; p1[4 * k_ - 13] = bk_ + sl3; } } \
            qkt<KB>(p0, p1, K_lds, r32, hi, qr); \
            if (own_) { const int dq_ = tq - 64 * tt_ - 4 * hi; \
                _Pragma("unroll") for (int r = 0; r < 16; ++r) { const int c_ = (r & 3) + 8 * (r >> 2); if (dq_ - c_ < 0) p0[r] = NEGI; if (dq_ - c_ - 32 < 0) p1[r] = NEGI; } } \
            else { const bool on_ = ((sel >> n_) & 1u) != 0u; \
                _Pragma("unroll") for (int r = 0; r < 16; ++r) { p0[r] = on_ ? p0[r] : NEGI; p1[r] = on_ ? p1[r] : NEGI; } } \
            float pmax_ = p0[0]; \
            _Pragma("unroll") for (int r = 1; r < 16; ++r) pmax_ = fmaxf(pmax_, p0[r]); \
            _Pragma("unroll") for (int r = 0; r < 16; ++r) pmax_ = fmaxf(pmax_, p1[r]); \
            { auto rr_ = __builtin_amdgcn_permlane32_swap(__float_as_uint(pmax_), __float_as_uint(pmax_), false, false); pmax_ = fmaxf(__uint_as_float(rr_[0]), __uint_as_float(rr_[1])); } \
            const float mn_ = fmaxf(m_reg, pmax_); const float alpha_ = __builtin_amdgcn_exp2f(m_reg - mn_); m_reg = mn_; \
            _Pragma("unroll") for (int r = 0; r < 16; ++r) { p0[r] = __builtin_amdgcn_exp2f(p0[r] - mn_); p1[r] = __builtin_amdgcn_exp2f(p1[r] - mn_); } \
            float ps_ = 0.f; \
            _Pragma("unroll") for (int r = 0; r < 16; ++r) ps_ += p0[r]; \
            _Pragma("unroll") for (int r = 0; r < 16; ++r) ps_ += p1[r]; \
            { auto rr_ = __builtin_amdgcn_permlane32_swap(__float_as_uint(ps_), __float_as_uint(ps_), false, false); ps_ = __uint_as_float(rr_[0]) + __uint_as_float(rr_[1]); } \
            l_reg = l_reg * alpha_ + ps_; \
            RESC(alpha_); \
            PK4(p0, 0, pa0); PK4(p0, 8, pa1); PK4(p1, 0, pa2); PK4(p1, 8, pa3); \
            pv_tile<KB>(o, vb0, pa0, pa1, pa2, pa3); \
        } \
        if ((t) + 1 < NT) { VM_WAIT(); TWRITE((KB) ^ 1); } \
        LDS_WAIT(); __syncthreads(); } while (0)
    for (int t = 0; t < NT; t += 2) { TILE_STEP(t, 0); TILE_STEP(t + 1, 1); }
    if (hi == 0) li_l[r32] = l_reg; asm volatile("s_waitcnt lgkmcnt(0)" ::: "memory");
    float rli[16];
#pragma unroll
    for (int r = 0; r < 16; ++r) rli[r] = __builtin_amdgcn_rcpf(li_l[crow(r, hi)]);
    bf16* Ow = MIX + (rowb + (size_t)(j * 256 + wid * 32)) * D + HW + h * HD;
#pragma unroll
    for (int r = 0; r < 16; ++r) { const int orow = crow(r, hi);
#pragma unroll
        for (int d0 = 0; d0 < 4; ++d0) { const float v = o[d0][r] * rli[r]; const float vn = __shfl_xor(v, 1);
            if ((r32 & 1) == 0) *(GAS unsigned*)(Ow + (size_t)orow * D + d0 * 32 + r32) = cvtpk(v, vn); } }
    LDS_WAIT(); __syncthreads();
#undef TLOAD
#undef TWRITE
#undef RESC
#undef PK4
#undef TILE_STEP
}
#undef KSWZ
#undef SBAR
}
__device__ __forceinline__ void moba_phase(Frame& F) {
    for (int p = F.vcu; p < BATCH * NHEAD * 8; p += F.G) {
        const int bh = p >> 3, s = p & 7, b = bh >> 4, h = bh & 15;
        for (int k = 0; k < 2; ++k) moba::unit(F.lds + RING_OFF, F.MQ, F.MK, F.MV, F.KMEAN, F.XN, b, h, k ? s : 15 - s);
    }
}


struct Args { const float* in[15]; float* out; unsigned char* ws; int ph_lo, ph_hi, li, pad; };
__global__ void __launch_bounds__(NWAVES * 64, 2) mk_fwd(Args args) {
    extern __shared__ __attribute__((aligned(16))) unsigned char lds[];
    Frame F;
    F.lds = (LAS unsigned char*)lds;
    F.MISC = (volatile LAS unsigned*)(F.lds + MISC_OFF);
    F.tid = threadIdx.x; F.lane = F.tid & 63; F.wave = __builtin_amdgcn_readfirstlane(F.tid >> 6);
    F.G = gridDim.x; { const int bx = blockIdx.x; F.vcu = (F.G % 8 == 0) ? (bx % 8) * (F.G / 8) + bx / 8 : bx; }
#define GRID_BAR(seam) do { if (N_LAUNCHES == PER_PHASE) { if (F.tid == 0) __hip_atomic_store(F.ctl + CW_TMO, 0xBADBA0u | (unsigned)(seam), RLX_AGENT); } \
    else { xcd_barrier(bar); } } while (0)
    unsigned char* ws = args.ws;
    F.ctl = (gu32*)(ws + WS_CTL);
    F.x = args.in[0]; F.n1 = args.in[1]; F.wg1 = args.in[2]; F.wu1 = args.in[3]; F.wd1 = args.in[4]; F.nmix = args.in[5]; F.win = args.in[6]; F.lbnd = args.in[7];
    F.hnorm = args.in[8]; F.wout = args.in[9]; F.n2 = args.in[10]; F.wg2 = args.in[11]; F.wu2 = args.in[12]; F.wd2 = args.in[13]; F.nfin = args.in[14]; F.out = args.out;
    F.WGU1 = (bf16*)(ws + WS_WGU1); F.WD1 = (bf16*)(ws + WS_WD1); F.WIN = (bf16*)(ws + WS_WIN); F.WOUT = (bf16*)(ws + WS_WOUT); F.WGU2 = (bf16*)(ws + WS_WGU2); F.WD2 = (bf16*)(ws + WS_WD2);
    F.XN = (bf16*)(ws + WS_XN); F.ACT = (bf16*)(ws + WS_ACT); F.QH = (bf16*)(ws + WS_QH); F.VH = (bf16*)(ws + WS_VH); F.GH = (bf16*)(ws + WS_GH);
    F.MQ = (bf16*)(ws + WS_MQ); F.MK = (bf16*)(ws + WS_MK); F.MV = (bf16*)(ws + WS_MV);
    F.FG = (float*)(ws + WS_F); F.ORAW = (float*)(ws + WS_ORAW); F.KMEAN = (float*)(ws + WS_KMEAN); F.KT = (bf16*)(ws + WS_KT); F.KTT = (bf16*)(ws + WS_KTT); F.DD = (float*)(ws + WS_DD);
    for (int u = F.tid; u < (LDS_BYTES - LDSCTL_OFF) / 4; u += NWAVES * 64) ((LAS unsigned*)(F.lds + LDSCTL_OFF))[u] = 0u;
    __syncthreads();
    XcdBarrier bar; bar.bar = (unsigned*)(F.ctl + CW_BAR); bar.x = 0; bar.st = nullptr;
    if (N_LAUNCHES != PER_PHASE) bar = xcd_barrier_post((unsigned*)(F.ctl + CW_BAR), F.MISC + 8);

    const int lo = args.ph_lo, hi = args.ph_hi;
#define IN(k) (lo <= (k) && (k) < hi)
#define BOTH(k) (IN(k) && IN((k) + 1))

    if (IN(0)) { p0_prologue(F); if (BOTH(0)) GRID_BAR(0); }
    if (IN(1)) {
        pg8::Gemm g{F.XN, F.WGU1, M, NGU, D}; pg8::StaticOrder S; S.init(M, NGU, F.G, (int)blockIdx.x);
        pg8::EpiSwiGLU E{F.ACT, FF};
        pg8::gemm_phase<pg8::EpiSwiGLU, pg8::StaticOrder, true, true>(F.lds + RING_OFF, g, S, E);
        if (BOTH(1)) GRID_BAR(1);
    }
    if (IN(2)) {
        pg8::Gemm g{F.ACT, F.WD1, M, D, FF}; pg8::StaticOrder S; S.init(M, D, F.G, (int)blockIdx.x);
        pg8::EpiResF32 E{F.x, F.out, D, 0.5f};
        pg8::gemm_phase<pg8::EpiResF32, pg8::StaticOrder, true, true>(F.lds + RING_OFF, g, S, E);
        if (BOTH(2)) GRID_BAR(2);
    }
    if (IN(3)) { norm_phase_bf16(F, F.out, F.nmix, F.XN); if (BOTH(3)) GRID_BAR(3); }
    if (IN(4)) {
        pg8::Gemm g{F.XN, F.WIN, M, NIN, D}; pg8::StaticOrder S; S.init(M, NIN, F.G, (int)blockIdx.x);
        pg8::EpiInProj E{F.QH, F.VH, F.GH, F.MQ, F.MK, F.MV, F.FG, F.lbnd};
        pg8::gemm_phase<pg8::EpiInProj, pg8::StaticOrder, true, true>(F.lds + RING_OFF, g, S, E);
        if (BOTH(4)) GRID_BAR(4);
    }
    if (IN(5)) { kmean_phase(F); hgrn_prepass_phase(F); if (BOTH(5)) GRID_BAR(5); }
    if (IN(6)) { hgrn_scan2_phase(F); moba_phase(F); if (BOTH(6)) GRID_BAR(6); }
    if (IN(7)) { hgrn_post_phase(F); if (BOTH(7)) GRID_BAR(7); }
    if (IN(8)) {
        pg8::Gemm g{F.XN, F.WOUT, M, D, D}; pg8::StaticOrder S; S.init(M, D, F.G, (int)blockIdx.x);
        pg8::EpiResF32 E{F.out, F.out, D, 1.0f};
        pg8::gemm_phase<pg8::EpiResF32, pg8::StaticOrder, true, true>(F.lds + RING_OFF, g, S, E);
        if (BOTH(8)) GRID_BAR(8);
    }
    if (IN(9)) { norm_phase_bf16(F, F.out, F.n2, F.XN); if (BOTH(9)) GRID_BAR(9); }
    if (IN(10)) {
        pg8::Gemm g{F.XN, F.WGU2, M, NGU, D}; pg8::StaticOrder S; S.init(M, NGU, F.G, (int)blockIdx.x);
        pg8::EpiSwiGLU E{F.ACT, FF};
        pg8::gemm_phase<pg8::EpiSwiGLU, pg8::StaticOrder, true, true>(F.lds + RING_OFF, g, S, E);
        if (BOTH(10)) GRID_BAR(10);
    }
    if (IN(11)) {
        pg8::Gemm g{F.ACT, F.WD2, M, D, FF}; pg8::StaticOrder S; S.init(M, D, F.G, (int)blockIdx.x);
        pg8::EpiResF32 E{F.out, F.out, D, 0.5f};
        pg8::gemm_phase<pg8::EpiResF32, pg8::StaticOrder, true, true>(F.lds + RING_OFF, g, S, E);
        if (BOTH(11)) GRID_BAR(11);
    }
    if (IN(12)) {
        const int gw = F.vcu * NWAVES + F.wave, NGW = F.G * NWAVES;
        for (int m = gw; m < M; m += NGW) rms_row_f32(F.out + (size_t)m * D, F.nfin, F.out + (size_t)m * D, F.lane);
    }
#undef IN
#undef BOTH
}

extern "C" void kernel_launch(void* const* d_in, const int* in_sizes, int n_in, void* d_out, int out_size, void* d_ws, size_t ws_size, hipStream_t stream) {
    static int grid = 0;
    if (grid == 0) {
        if (n_in != 15 || in_sizes[0] != M * D || out_size != M * D || ws_size < WS_END) { fprintf(stderr, "kernel_launch: shape/workspace mismatch (n_in %d, in0 %d, out %d, ws %zu); nothing launched\n", n_in, n_in > 0 ? in_sizes[0] : -1, out_size, ws_size); grid = -1; return; }
        int dev = 0, cus = 0, per_cu = 0;
        if (hipGetDevice(&dev) != hipSuccess || hipDeviceGetAttribute(&cus, hipDeviceAttributeMultiprocessorCount, dev) != hipSuccess) { fprintf(stderr, "kernel_launch: device query failed\n"); grid = -1; return; }
        if (hipFuncSetAttribute((const void*)mk_fwd, hipFuncAttributeMaxDynamicSharedMemorySize, LDS_BYTES) != hipSuccess) { fprintf(stderr, "kernel_launch: hipFuncSetAttribute failed\n"); grid = -1; return; }
        if (hipOccupancyMaxActiveBlocksPerMultiprocessor(&per_cu, (const void*)mk_fwd, NWAVES * 64, LDS_BYTES) != hipSuccess || per_cu < 1)
            fprintf(stderr, "kernel_launch: note: occupancy query reports %d workgroups per CU\n", per_cu);
        (void)hipGetLastError();
        grid = cus;
    }
    if (grid < 0) return;
    if (hipMemsetAsync((char*)d_ws + WS_CTL, 0, CTL_ZERO_BYTES, stream) != hipSuccess) { fprintf(stderr, "kernel_launch: hipMemsetAsync failed\n"); return; }
    Args a{};
    for (int i = 0; i < 15; ++i) a.in[i] = (const float*)d_in[i];
    a.out = (float*)d_out; a.ws = (unsigned char*)d_ws;
    for (int li = 0; li < N_LAUNCHES; ++li) {
        a.ph_lo = (N_LAUNCHES == PER_PHASE) ? li : 0; a.ph_hi = (N_LAUNCHES == PER_PHASE) ? li + 1 : PER_PHASE; a.li = li;
        hipLaunchKernelGGL(mk_fwd, dim3(grid), dim3(NWAVES * 64), LDS_BYTES, stream, a);
        const hipError_t le = hipPeekAtLastError();
        if (le != hipSuccess) { fprintf(stderr, "kernel_launch: launch %d failed: %s\n", li, hipGetErrorName(le)); break; }
    }
}
```

```cpp
#include <hip/hip_runtime.h>
#include <cstdio>
#include <cstdint>
namespace pg8 {
#define PG8_LAS __attribute__((address_space(3)))
typedef unsigned short bf16_t;
typedef short bf16x8 __attribute__((ext_vector_type(8)));
typedef float f32x4 __attribute__((ext_vector_type(4)));
typedef unsigned u32x4 __attribute__((ext_vector_type(4)));
constexpr int BM = 256, BK = 64, HALF = 128, HTB = HALF * BK * 2  , STAGE_BYTES = 8 * HTB, NXCD = 8, WGM = 8;

__host__ __device__ __forceinline__ int lds_byte(int r, int c) { const int st = (r >> 4) * 2 + (c >> 5), rr = r & 15, cc = c & 31, ob = rr * 64 + cc * 2; return st * 1024 + (ob ^ (((ob >> 9) & 1) << 5)); }
__host__ __device__ __forceinline__ void stage_rc(int b, int& R, int& C) { const int st = b / 1024, sb = b % 1024, swz = sb ^ (((sb >> 9) & 1) << 5); R = (st >> 1) * 16 + swz / 64; C = (st & 1) * 32 + (swz % 64) / 2; }
__host__ __device__ __forceinline__ int perm32(int rho) { const int n = rho >> 4, i = rho & 15; return 8 * (i >> 2) + 4 * n + (i & 3); }

struct Unit { int pm, pn; };
struct Gemm { const bf16_t* A; const bf16_t* Bt; int M, N, K; };

struct StaticOrder {
    int nM, nN, nwg, G, c;
    __host__ __device__ void init(int M, int N, int G_, int c_) { nM = M / BM; nN = N / BM; nwg = nM * nN; G = G_; c = c_; }
    __host__ __device__ bool next(int i, Unit& u) const {
        const long L = (long)i * G + c; if (L >= nwg) return false;
        int wgid = (int)L; { const int q = nwg / NXCD, r = nwg % NXCD, xcd = wgid % NXCD, off = wgid / NXCD; wgid = (xcd < r ? xcd * (q + 1) : r * (q + 1) + (xcd - r) * q) + off; }
        const int nig = WGM * nN, gid = wgid / nig, fm = gid * WGM, gsz = (nM - fm) < WGM ? (nM - fm) : WGM;
        u.pm = fm + ((wgid % nig) % gsz); u.pn = (wgid % nig) / gsz; return true;
    }
    __device__ __forceinline__ void a_ready(const Unit&) const {}
    __device__ __forceinline__ void done(const Unit&) const {}
};

__device__ __forceinline__ unsigned cvt_pk_bf16(float lo, float hi) { unsigned r; asm volatile("v_cvt_pk_bf16_f32 %0, %1, %2" : "=v"(r) : "v"(lo), "v"(hi)); return r; }
typedef float f32x2 __attribute__((ext_vector_type(2)));

__device__ __forceinline__ float sigmoid_fast(float a) { return __builtin_amdgcn_rcpf(1.0f + __builtin_amdgcn_exp2f(-1.4426950408889634f * a)); }

struct EpiSwiGLU {
    static constexpr bool PERM = true, AFTER_DRAIN = false;
    bf16_t* O; int ldc;
    __device__ __forceinline__ void operator()(const f32x4 (&acc)[2][2][4][2], const Unit& u, int wr, int wc, int fr, int fq) const {
        const int row0 = u.pm * BM + wr * 64 + fr, col0 = u.pn * HALF + wc * 32 + 8 * fq;
#pragma unroll
        for (int ai = 0; ai < 2; ++ai)
#pragma unroll
            for (int m = 0; m < 4; ++m) { bf16_t* rowp = O + (size_t)(row0 + ai * HALF + m * 16) * ldc + col0;
                f32x4 v0, v1;
#pragma unroll
                for (int i = 0; i < 4; ++i) { const float g0 = acc[ai][0][m][0][i], g1 = acc[ai][0][m][1][i];
                    v0[i] = g0 * sigmoid_fast(g0) * acc[ai][1][m][0][i]; v1[i] = g1 * sigmoid_fast(g1) * acc[ai][1][m][1][i]; }
                u32x4 w; w.x = cvt_pk_bf16(v0[0], v0[1]); w.y = cvt_pk_bf16(v0[2], v0[3]); w.z = cvt_pk_bf16(v1[0], v1[1]); w.w = cvt_pk_bf16(v1[2], v1[3]);
                *(u32x4*)rowp = w; }
    }
};

struct EpiResF32 {
    static constexpr bool PERM = false, AFTER_DRAIN = false;
    const float* base; float* out; int ldc; float alpha;
    __device__ __forceinline__ void operator()(const f32x4 (&acc)[2][2][4][2], const Unit& u, int wr, int wc, int fr, int fq) const {
        const int row0 = u.pm * BM + wr * 64 + fr, col0 = u.pn * BM + wc * 32 + 4 * fq;
#pragma unroll
        for (int ai = 0; ai < 2; ++ai)
#pragma unroll
            for (int m = 0; m < 4; ++m) { const size_t off = (size_t)(row0 + ai * HALF + m * 16) * ldc + col0;
                f32x4 bs[2][2];
#pragma unroll
                for (int bj = 0; bj < 2; ++bj)
#pragma unroll
                    for (int n = 0; n < 2; ++n) bs[bj][n] = *(const f32x4*)(base + off + bj * HALF + n * 16);
#pragma unroll
                for (int bj = 0; bj < 2; ++bj)
#pragma unroll
                    for (int n = 0; n < 2; ++n) *(f32x4*)(out + off + bj * HALF + n * 16) = bs[bj][n] + acc[ai][bj][m][n] * alpha;
                asm volatile("" ::: "memory"); }
    }
};

struct EpiInProj {
    static constexpr bool PERM = true, AFTER_DRAIN = false;
    bf16_t* QH; bf16_t* VH; bf16_t* GH; bf16_t* MQ; bf16_t* MK; bf16_t* MV; float* F; const float* lbnd;
    __device__ __forceinline__ void operator()(const f32x4 (&acc)[2][2][4][2], const Unit& u, int wr, int wc, int fr, int fq) const {
        const int seg = u.pn >> 3, cs = (u.pn & 7) * BM + wc * 32 + 8 * fq, row0 = u.pm * BM + wr * 64 + fr;
        if (seg == 1) {
            float lb[2][8];
#pragma unroll
            for (int bj = 0; bj < 2; ++bj)
#pragma unroll
                for (int n = 0; n < 2; ++n) { const f32x4 a = *(const f32x4*)(lbnd + cs + bj * HALF + 4 * n), b = *(const f32x4*)(lbnd + 2048 + cs + bj * HALF + 4 * n);
#pragma unroll
                    for (int i = 0; i < 4; ++i) lb[bj][4 * n + i] = sigmoid_fast(a[i] - b[i]); }
#pragma unroll
            for (int ai = 0; ai < 2; ++ai)
#pragma unroll
                for (int m = 0; m < 4; ++m) { float* rowp = F + (size_t)(row0 + ai * HALF + m * 16) * 2048 + cs;
#pragma unroll
                    for (int bj = 0; bj < 2; ++bj)
#pragma unroll
                        for (int n = 0; n < 2; ++n) { f32x4 o;
#pragma unroll
                            for (int i = 0; i < 4; ++i) { const float l = lb[bj][4 * n + i]; o[i] = l + (1.0f - l) * sigmoid_fast(acc[ai][bj][m][n][i]); }
                            *(f32x4*)(rowp + bj * HALF + 4 * n) = o; } }
        } else {
            bf16_t* base = QH; float sc = 0.08838834764831845f; bool act = true;
            if (seg == 2) { base = VH; sc = 1.f; act = false; }
            else if (seg == 3) { base = GH; sc = 1.f; act = true; }
            else if (seg == 4) { base = MQ; sc = 0.08838834764831845f * 1.4426950408889634f; act = false; }
            else if (seg == 5) { base = MK; sc = 1.f; act = false; }
            else if (seg == 6) { base = MV; sc = 1.f; act = false; }
#pragma unroll
            for (int ai = 0; ai < 2; ++ai)
#pragma unroll
                for (int m = 0; m < 4; ++m) { bf16_t* rowp = base + (size_t)(row0 + ai * HALF + m * 16) * 2048 + cs;
#pragma unroll
                    for (int bj = 0; bj < 2; ++bj) { f32x4 v0 = acc[ai][bj][m][0], v1 = acc[ai][bj][m][1];
                        if (act) {
#pragma unroll
                            for (int i = 0; i < 4; ++i) { v0[i] = v0[i] * sigmoid_fast(v0[i]); v1[i] = v1[i] * sigmoid_fast(v1[i]); } }
                        v0 = v0 * sc; v1 = v1 * sc;
                        u32x4 w; w.x = cvt_pk_bf16(v0[0], v0[1]); w.y = cvt_pk_bf16(v0[2], v0[3]); w.z = cvt_pk_bf16(v1[0], v1[1]); w.w = cvt_pk_bf16(v1[2], v1[3]);
                        *(u32x4*)(rowp + bj * HALF) = w; } }
        }
    }
};

template <class Epi, class Sched, bool ALIGN_EPI = false, bool SP2 = false>
__device__ __forceinline__ void gemm_phase(PG8_LAS unsigned char* lds, const Gemm g, const Sched& S, const Epi& E) {
    const int tid = threadIdx.x, wid = __builtin_amdgcn_readfirstlane(tid >> 6), lane = tid & 63, wr = wid >> 2, wc = wid & 3, fr = lane & 15, fq = lane >> 4;
    const int K = g.K, nt = K / BK;
    unsigned voffA[2], voffB[2];
#pragma unroll
    for (int i = 0; i < 2; ++i) { int R, C; stage_rc(tid * 16 + i * 8192, R, C); const int Rb = Epi::PERM ? ((R & ~31) + perm32(R & 31)) : R;
        voffA[i] = (unsigned)(R * K + C) * 2u; voffB[i] = (unsigned)(Rb * K + C) * 2u; }
    const size_t kstep = (size_t)(BK * 2);
    const size_t hstep = (size_t)HALF * K * 2;
    const size_t tstep = 2 * hstep;
    const unsigned ldsw = (unsigned)wid * 1024u;
    const int aoff = lds_byte(wr * 64 + fr, fq * 8), boff = lds_byte(wc * 32 + fr, fq * 8);
#define PG8_SA(b, h) (((b) * 2 + (h)) * HTB)
#define PG8_SB(b, h) ((4 + (b) * 2 + (h)) * HTB)
#define PG8_STAGE(bufoff, gbase, voff) do { _Pragma("unroll") for (int _i = 0; _i < 2; ++_i) \
        __builtin_amdgcn_global_load_lds((const unsigned*)((const char*)(gbase) + (voff)[_i]), (PG8_LAS unsigned*)(lds + (bufoff) + ldsw + _i * 8192), 16, 0, 0); } while (0)
#define PG8_LDA(dst, b, h) do { _Pragma("unroll") for (int m = 0; m < 4; ++m) _Pragma("unroll") for (int k = 0; k < 2; ++k) dst[m][k] = *(const PG8_LAS bf16x8*)(lds + PG8_SA(b, h) + aoff + m * 2048 + k * 1024); } while (0)
#define PG8_LDB(dst, b, h) do { _Pragma("unroll") for (int n = 0; n < 2; ++n) _Pragma("unroll") for (int k = 0; k < 2; ++k) dst[n][k] = *(const PG8_LAS bf16x8*)(lds + PG8_SB(b, h) + boff + n * 2048 + k * 1024); } while (0)
#define PG8_MMA(ai, bj, At, Bt) do { __builtin_amdgcn_s_setprio(1); _Pragma("unroll") for (int m = 0; m < 4; ++m) _Pragma("unroll") for (int n = 0; n < 2; ++n) _Pragma("unroll") for (int k = 0; k < 2; ++k) \
        acc[ai][bj][m][n] = __builtin_amdgcn_mfma_f32_16x16x32_bf16(Bt[n][k], At[m][k], acc[ai][bj][m][n], 0, 0, 0); __builtin_amdgcn_s_setprio(0); } while (0)
#define PG8_WAIT_V(n) asm volatile("s_waitcnt vmcnt(" #n ")" ::: "memory")
#define PG8_WAIT_L(n) asm volatile("s_waitcnt lgkmcnt(" #n ")" ::: "memory")
#define PG8_BAR __builtin_amdgcn_s_barrier()
#define PG8_SCHED __builtin_amdgcn_sched_barrier(0)
    Unit cur, nxt; int ui = 0;
    if (!S.next(0, cur)) return;
    f32x4 acc[2][2][4][2];
#pragma unroll
    for (int a = 0; a < 2; ++a)
#pragma unroll
        for (int b = 0; b < 2; ++b)
#pragma unroll
            for (int m = 0; m < 4; ++m)
#pragma unroll
                for (int n = 0; n < 2; ++n) acc[a][b][m][n] = (f32x4){0.f, 0.f, 0.f, 0.f};
    bf16x8 At[4][2], B0[2][2], B1[2][2];
    const char* cA = (const char*)g.A + (size_t)cur.pm * tstep; const char* cB = (const char*)g.Bt + (size_t)cur.pn * tstep;
    S.a_ready(cur);
    if constexpr (SP2) {
        PG8_STAGE(PG8_SB(0, 0), cB, voffB); PG8_STAGE(PG8_SB(0, 1), cB + hstep, voffB); PG8_STAGE(PG8_SA(0, 0), cA, voffA); PG8_STAGE(PG8_SA(0, 1), cA + hstep, voffA);
        if (wr == 1) PG8_BAR;
        PG8_WAIT_V(2); PG8_BAR;
        PG8_STAGE(PG8_SB(1, 0), cB + kstep, voffB); PG8_STAGE(PG8_SA(1, 0), cA + kstep, voffA); PG8_STAGE(PG8_SB(1, 1), cB + hstep + kstep, voffB);
        PG8_WAIT_V(6); PG8_BAR;
    } else {
        PG8_STAGE(PG8_SB(0, 0), cB, voffB); PG8_STAGE(PG8_SA(0, 0), cA, voffA); PG8_STAGE(PG8_SB(0, 1), cB + hstep, voffB); PG8_STAGE(PG8_SA(0, 1), cA + hstep, voffA);
        if (wr == 1) PG8_BAR;
        PG8_WAIT_V(4); PG8_BAR;
        PG8_STAGE(PG8_SB(1, 0), cB + kstep, voffB); PG8_STAGE(PG8_SA(1, 0), cA + kstep, voffA); PG8_STAGE(PG8_SB(1, 1), cB + hstep + kstep, voffB);
        PG8_WAIT_V(6); PG8_BAR;
    }
    for (;;) {
        const bool has_next = S.next(ui + 1, nxt);
        const char* nA = has_next ? (const char*)g.A + (size_t)nxt.pm * tstep : cA; const char* nB = has_next ? (const char*)g.Bt + (size_t)nxt.pn * tstep : cB;
        for (int t = 0; t < nt; t += 2) {
            const bool last = (t == nt - 2);
            const char* a1 = cA + (size_t)(t + 1) * kstep;
            const char* a2 = last ? nA : cA + (size_t)(t + 2) * kstep; const char* b2 = last ? nB : cB + (size_t)(t + 2) * kstep;
            const char* a3 = a2 + kstep; const char* b3 = b2 + kstep;
            if (last && has_next) S.a_ready(nxt);
            if constexpr (SP2) {
            PG8_LDB(B0, 0, 0); PG8_LDB(B1, 0, 1); PG8_SCHED; PG8_LDA(At, 0, 0); PG8_STAGE(PG8_SA(1, 1), a1 + hstep, voffA);
            PG8_WAIT_V(8); PG8_WAIT_L(0); PG8_BAR; PG8_MMA(0, 0, At, B0); PG8_MMA(0, 1, At, B1); PG8_BAR; PG8_SCHED;
            PG8_LDA(At, 0, 1); PG8_STAGE(PG8_SB(0, 0), b2, voffB); PG8_STAGE(PG8_SB(0, 1), b2 + hstep, voffB); PG8_STAGE(PG8_SA(0, 0), a2, voffA);
            PG8_WAIT_V(8); PG8_WAIT_L(0); PG8_BAR; PG8_MMA(1, 0, At, B0); PG8_MMA(1, 1, At, B1); PG8_BAR; PG8_SCHED;
            PG8_LDB(B0, 1, 0); PG8_LDB(B1, 1, 1); PG8_SCHED; PG8_LDA(At, 1, 0); PG8_STAGE(PG8_SA(0, 1), a2 + hstep, voffA);
            PG8_WAIT_V(8); PG8_WAIT_L(0); PG8_BAR; PG8_MMA(0, 0, At, B0); PG8_MMA(0, 1, At, B1); PG8_BAR; PG8_SCHED;
            PG8_LDA(At, 1, 1); PG8_STAGE(PG8_SB(1, 0), b3, voffB); PG8_STAGE(PG8_SB(1, 1), b3 + hstep, voffB); PG8_STAGE(PG8_SA(1, 0), a3, voffA);
            PG8_WAIT_V(8); PG8_WAIT_L(0); PG8_BAR; PG8_MMA(1, 0, At, B0); PG8_MMA(1, 1, At, B1); PG8_BAR; PG8_SCHED;
            } else {
            PG8_LDB(B0, 0, 0); PG8_SCHED; PG8_LDA(At, 0, 0); PG8_STAGE(PG8_SA(1, 1), a1 + hstep, voffA);
            PG8_WAIT_L(8); PG8_BAR; PG8_WAIT_L(0); PG8_MMA(0, 0, At, B0); PG8_BAR; PG8_SCHED;
            PG8_LDB(B1, 0, 1); PG8_STAGE(PG8_SB(0, 0), b2, voffB);
            PG8_BAR; PG8_WAIT_L(0); PG8_MMA(0, 1, At, B1); PG8_BAR;
            PG8_LDA(At, 0, 1); PG8_STAGE(PG8_SA(0, 0), a2, voffA);
            PG8_BAR; PG8_WAIT_L(0); PG8_MMA(1, 0, At, B0); PG8_BAR; PG8_SCHED;
            PG8_STAGE(PG8_SB(0, 1), b2 + hstep, voffB);
            PG8_WAIT_V(6); PG8_BAR; PG8_MMA(1, 1, At, B1); PG8_BAR;
            PG8_LDB(B0, 1, 0); PG8_SCHED; PG8_LDA(At, 1, 0); PG8_STAGE(PG8_SA(0, 1), a2 + hstep, voffA);
            PG8_WAIT_L(8); PG8_BAR; PG8_WAIT_L(0); PG8_MMA(0, 0, At, B0); PG8_BAR; PG8_SCHED;
            PG8_LDB(B1, 1, 1); PG8_STAGE(PG8_SB(1, 0), b3, voffB);
            PG8_BAR; PG8_WAIT_L(0); PG8_MMA(0, 1, At, B1); PG8_BAR;
            PG8_LDA(At, 1, 1); PG8_STAGE(PG8_SA(1, 0), a3, voffA);
            PG8_BAR; PG8_WAIT_L(0); PG8_MMA(1, 0, At, B0); PG8_BAR; PG8_SCHED;
            PG8_STAGE(PG8_SB(1, 1), b3 + hstep, voffB);
            PG8_WAIT_V(6); PG8_BAR; PG8_MMA(1, 1, At, B1); PG8_BAR;
            }
        }
        if constexpr (ALIGN_EPI) { if (wr == 0) PG8_BAR; }
        if constexpr (!Epi::AFTER_DRAIN) { E(acc, cur, wr, wc, fr, fq); S.done(cur); }
        if (!has_next) break;
#pragma unroll
        for (int a = 0; a < 2; ++a)
#pragma unroll
            for (int b = 0; b < 2; ++b)
#pragma unroll
                for (int m = 0; m < 4; ++m)
#pragma unroll
                    for (int n = 0; n < 2; ++n) acc[a][b][m][n] = (f32x4){0.f, 0.f, 0.f, 0.f};
        cur = nxt; cA = nA; cB = nB; ++ui;
        if constexpr (ALIGN_EPI) { if (wr == 1) PG8_BAR; }
    }
    PG8_WAIT_V(0);
    if constexpr (!ALIGN_EPI) { if (wr == 0) PG8_BAR; }
    PG8_BAR;
    if constexpr (Epi::AFTER_DRAIN) { E.fused(acc, cur, wr, wc, fr, fq, lds, wid, lane); S.done(cur); }
#undef PG8_SA
#undef PG8_SB
#undef PG8_STAGE
#undef PG8_LDA
#undef PG8_LDB
#undef PG8_MMA
#undef PG8_WAIT_V
#undef PG8_WAIT_L
#undef PG8_BAR
#undef PG8_SCHED
}
}

constexpr int NWAVES = 8;
#ifndef MK_N_LAUNCHES
#define MK_N_LAUNCHES 1
#endif
constexpr int PER_PHASE = 12;
constexpr int N_LAUNCHES = MK_N_LAUNCHES;

constexpr int BATCH = 4, SEQ = 4096, D = 4096, FF = 11008, NGU = 2 * FF, NIN = 14336, HW = 2048, NHEAD = 16, HD = 128;
constexpr int M = BATCH * SEQ;
constexpr float RMS_EPS = 1e-6f;

constexpr size_t MiB = 1u << 20;
constexpr size_t WS_CTL = 0, CTL_ZERO_BYTES = 1 * MiB;
constexpr size_t WS_KMEAN = 1 * MiB;
constexpr size_t WS_WGU1 = 2 * MiB, WS_WD1 = 174 * MiB, WS_WIN = 260 * MiB, WS_WOUT = 372 * MiB, WS_WGU2 = 404 * MiB, WS_WD2 = 576 * MiB;
constexpr size_t WS_XN = 662 * MiB;
constexpr size_t WS_ACT = 790 * MiB;
constexpr size_t WS_QH = WS_ACT, WS_VH = WS_ACT + 64 * MiB, WS_GH = WS_ACT + 128 * MiB, WS_MQ = WS_ACT + 192 * MiB, WS_MK = WS_ACT + 256 * MiB, WS_MV = WS_ACT + 320 * MiB;
constexpr size_t WS_F = 1238 * MiB;
constexpr size_t WS_ORAW = 1366 * MiB;
constexpr size_t WS_KT = 1174 * MiB;
constexpr size_t WS_KTT = 1494 * MiB;
constexpr size_t WS_DD = 1558 * MiB;
constexpr size_t WS_END = 1560 * MiB;
static_assert(WS_WGU1 + (size_t)NGU * D * 2 <= WS_WD1 && WS_WD1 + (size_t)D * FF * 2 <= WS_WIN && WS_WIN + (size_t)NIN * D * 2 <= WS_WOUT && WS_WOUT + (size_t)D * D * 2 <= WS_WGU2 &&
              WS_WGU2 + (size_t)NGU * D * 2 <= WS_WD2 && WS_WD2 + (size_t)D * FF * 2 <= WS_XN && WS_XN + (size_t)M * D * 2 <= WS_ACT && WS_ACT + (size_t)M * FF * 2 <= WS_F &&
              WS_MV + (size_t)M * HW * 2 <= WS_F && WS_F + (size_t)M * HW * 4 <= WS_ORAW && WS_ORAW + (size_t)M * HW * 4 <= WS_KTT && WS_KT + (size_t)M * HW * 2 <= WS_F && WS_KT >= WS_MV + (size_t)M * HW * 2 && WS_KTT + (size_t)M * HW * 2 <= WS_DD && WS_DD + (size_t)M / 64 * HW * 4 <= WS_END, "d_ws map");
constexpr int CW_TMO = 0, CW_CODE = 1;
constexpr int CW_QCTR = 8192;
constexpr int CW_BAR = 4096;

constexpr int RING_OFF = 0, RING_BYTES = 131072;
constexpr int LDSCTL_OFF = RING_BYTES, MISC_OFF = LDSCTL_OFF + 320;
constexpr int LDS_BYTES = 147456;
static_assert(MISC_OFF + 128 <= LDS_BYTES, "LDS map");

#define GAS __attribute__((address_space(1)))
#define LAS __attribute__((address_space(3)))
typedef unsigned short bf16;
typedef unsigned v4u __attribute__((ext_vector_type(4)));
typedef float f32x4 __attribute__((ext_vector_type(4)));
typedef short bf16x8 __attribute__((ext_vector_type(8)));
typedef GAS unsigned gu32;
typedef GAS unsigned long long gu64;
#define RLX_AGENT __ATOMIC_RELAXED, __HIP_MEMORY_SCOPE_AGENT
#define LDS_WAIT() asm volatile("s_waitcnt lgkmcnt(0)" ::: "memory")
#define VM_WAIT() asm volatile("s_waitcnt vmcnt(0)" ::: "memory")
__device__ __forceinline__ unsigned long long rt() { return __builtin_amdgcn_s_memrealtime(); }
__device__ __forceinline__ unsigned f2bf(float f) { unsigned u = __builtin_bit_cast(unsigned, f); return (u + 0x7fffu + ((u >> 16) & 1u)) >> 16; }
__device__ __forceinline__ unsigned pk2(float lo, float hi) { return f2bf(lo) | (f2bf(hi) << 16); }

#define XB_TMO      128
#define XB_XCNT(j)  (256  + 64 * (j))
#define XB_XSUB(j)  (1280 + 64 * (j))
#define XB_XGEN(j)  (2304 + 64 * (j))
#define XB_TOP      3328
#define XB_TOPGEN   3392
#define XCD_BAR_WORDS 3456
#define XB_SPIN_CAP (1u << 18)

__device__ __forceinline__ unsigned xb_ld(unsigned* p)              { return __hip_atomic_load(p, __ATOMIC_RELAXED, __HIP_MEMORY_SCOPE_AGENT); }
__device__ __forceinline__ unsigned xb_add(unsigned* p, unsigned v) { return __hip_atomic_fetch_add(p, v, __ATOMIC_RELAXED, __HIP_MEMORY_SCOPE_AGENT); }
__device__ __forceinline__ unsigned xb_xcc_id() { return (unsigned)__builtin_amdgcn_s_getreg((3 << 11) | 20) & 0xFu; }
#define XB_SPIN(cond, bar) do { unsigned _sp = 0; while (cond) { __builtin_amdgcn_s_sleep(1); \
    if ((++_sp & 255u) == 0u) { if (xb_ld(&(bar)[XB_TMO])) break; if (_sp > XB_SPIN_CAP) { atomicAdd(&(bar)[XB_TMO], 1u); break; } } } } while (0)

struct XcdBarrier {
    unsigned* bar; unsigned x;
    volatile LAS unsigned* st;
};

__device__ __forceinline__ XcdBarrier xcd_barrier_post(unsigned* bar, volatile LAS unsigned* st) {
    XcdBarrier b; b.bar = bar; b.x = xb_xcc_id(); b.st = st;
    if (threadIdx.x == 0) (void)xb_add(&bar[XB_XCNT(b.x)], 1u);
    return b;
}
__device__ __forceinline__ void xcd_barrier_complete(unsigned* bar, unsigned x, unsigned& nloc, unsigned& nx) {
    const unsigned G = gridDim.x * gridDim.y * gridDim.z;
    unsigned sum, cnt, mine, sp = 0u;
    for (;;) {
        sum = 0u; cnt = 0u; mine = 0u;
#pragma unroll
        for (unsigned j = 0; j < 16; ++j) { const unsigned c = xb_ld(&bar[XB_XCNT(j)]); sum += c; cnt += (c > 0u) ? 1u : 0u; mine = (j == x) ? c : mine; }
        if (sum == G) break;
        __builtin_amdgcn_s_sleep(1);
        if ((++sp & 255u) == 0u) { if (xb_ld(&bar[XB_TMO])) break; if (sp > XB_SPIN_CAP) { atomicAdd(&bar[XB_TMO], 1u); break; } }
    }
    nloc = mine > 0u ? mine : 1u; nx = cnt > 0u ? cnt : 1u;
}

__device__ __forceinline__ void xcd_barrier(const XcdBarrier& b) {
    asm volatile("s_waitcnt vmcnt(0)" ::: "memory");
    __syncthreads();
    if (threadIdx.x == 0) {
        unsigned* bar = b.bar;
        __builtin_amdgcn_s_waitcnt(0);
        unsigned nloc = b.st[0], nx = b.st[1];
        if (nloc == 0u) { xcd_barrier_complete(bar, b.x, nloc, nx); b.st[0] = nloc; b.st[1] = nx; }
        const unsigned old = xb_add(&bar[XB_XSUB(b.x)], 1u);
        const unsigned gen = old / nloc;
        if (old + 1u == (gen + 1u) * nloc) {
            __builtin_amdgcn_fence(__ATOMIC_RELEASE, "agent");
            asm volatile("s_waitcnt vmcnt(0)" ::: "memory");
            const unsigned og = xb_add(&bar[XB_TOP], 1u);
            const unsigned tg = og / nx;
            if (og + 1u == (tg + 1u) * nx) xb_add(&bar[XB_TOPGEN], 1u);
            else XB_SPIN(xb_ld(&bar[XB_TOPGEN]) == tg, bar);
            __builtin_amdgcn_fence(__ATOMIC_ACQUIRE, "agent");
            xb_add(&bar[XB_XGEN(b.x)], 1u);
            asm volatile("s_waitcnt vmcnt(0)" ::: "memory");
        } else {
            XB_SPIN(xb_ld(&bar[XB_XGEN(b.x)]) == gen, bar);
            __builtin_amdgcn_fence(__ATOMIC_ACQUIRE, "agent");
            asm volatile("s_waitcnt vmcnt(0)" ::: "memory");
        }
    }
    __syncthreads();
}

typedef float f32x16 __attribute__((ext_vector_type(16)));
typedef short s16x4 __attribute__((ext_vector_type(4)));
typedef unsigned v2u __attribute__((ext_vector_type(2)));
typedef float f32x2 __attribute__((ext_vector_type(2)));
struct Frame {
    LAS unsigned char* lds;
    volatile LAS unsigned* MISC;
    gu32* ctl;
    int tid, lane, wave;
    int vcu, G;
    const float* x; float* out;
    const float *n1, *wg1, *wu1, *wd1, *nmix, *win, *lbnd, *hnorm, *wout, *n2, *wg2, *wu2, *wd2, *nfin;
    bf16 *WGU1, *WD1, *WIN, *WOUT, *WGU2, *WD2;
    bf16 *XN, *ACT, *QH, *VH, *GH, *MQ, *MK, *MV;
    bf16 *KT, *KTT;
    float *FG, *ORAW, *KMEAN, *DD;
};

__device__ __forceinline__ float wave_sum(float v) {
#pragma unroll
    for (int o = 1; o < 64; o <<= 1) v += __shfl_xor(v, o);
    return v;
}
__device__ __forceinline__ float bf_lo(unsigned w) { return __builtin_bit_cast(float, w << 16); }
__device__ __forceinline__ float bf_hi(unsigned w) { return __builtin_bit_cast(float, w & 0xffff0000u); }

__device__ __forceinline__ void p0_transpose_item(const float* W, int K, int N, bf16* WT, int mode, LAS float* scr, int item, int lane) {
    const int nblk = N / 32, kb = item / nblk, nb = item % nblk, k0 = 64 * kb, n0 = 32 * nb;
    const int rbase = (mode == 0) ? n0 : (256 * (n0 >> 7) + (n0 & 127) + (mode == 2 ? 128 : 0));
#pragma unroll 8
    for (int i = 0; i < 32; ++i) { const int kk = 2 * i + (lane >> 5); scr[kk * 33 + (lane & 31)] = W[(size_t)(k0 + kk) * N + n0 + (lane & 31)]; }
    LDS_WAIT(); asm volatile("" ::: "memory");
    const int c = lane & 7;
#pragma unroll
    for (int j = 0; j < 4; ++j) { const int n = (lane >> 3) + 8 * j; const LAS float* s = scr + (8 * c) * 33 + n;
        v4u o; o.x = pk2(s[0 * 33], s[1 * 33]); o.y = pk2(s[2 * 33], s[3 * 33]); o.z = pk2(s[4 * 33], s[5 * 33]); o.w = pk2(s[6 * 33], s[7 * 33]);
        *(GAS v4u*)(WT + (size_t)(rbase + n) * K + k0 + 8 * c) = o; }
    LDS_WAIT(); asm volatile("" ::: "memory");
}
__device__ __forceinline__ void rms_row_bf16(const float* xrow, const float* g, bf16* orow, int lane) {
    const GAS f32x4* xr = (const GAS f32x4*)xrow + lane; const GAS f32x4* gr = (const GAS f32x4*)g + lane;
    f32x4 v[16]; float s = 0.f;
#pragma unroll
    for (int j = 0; j < 16; ++j) { v[j] = xr[64 * j]; s += (v[j].x * v[j].x + v[j].y * v[j].y) + (v[j].z * v[j].z + v[j].w * v[j].w); }
    const float r = 1.f / sqrtf(wave_sum(s) * (1.f / D) + RMS_EPS);
    GAS v2u* o8 = (GAS v2u*)orow + lane;
#pragma unroll
    for (int j = 0; j < 16; ++j) { const f32x4 gv = gr[64 * j]; v2u w; w.x = pk2(v[j].x * r * gv.x, v[j].y * r * gv.y); w.y = pk2(v[j].z * r * gv.z, v[j].w * r * gv.w); o8[64 * j] = w; }
}
__device__ __forceinline__ void rms_row_f32(const float* xrow, const float* g, float* orow, int lane) {
    const GAS f32x4* xr = (const GAS f32x4*)xrow + lane; const GAS f32x4* gr = (const GAS f32x4*)g + lane;
    f32x4 v[16]; float s = 0.f;
#pragma unroll
    for (int j = 0; j < 16; ++j) { v[j] = xr[64 * j]; s += (v[j].x * v[j].x + v[j].y * v[j].y) + (v[j].z * v[j].z + v[j].w * v[j].w); }
    const float r = 1.f / sqrtf(wave_sum(s) * (1.f / D) + RMS_EPS);
    GAS f32x4* o = (GAS f32x4*)orow + lane;
#pragma unroll
    for (int j = 0; j < 16; ++j) { const f32x4 gv = gr[64 * j]; o[64 * j] = (v[j] * r) * gv; }
}
__device__ __forceinline__ void norm_phase_bf16(Frame& F, const float* src, const float* g, bf16* dst) {
    const int gw = F.vcu * NWAVES + F.wave, NGW = F.G * NWAVES;
    for (int m = gw; m < M; m += NGW) rms_row_bf16(src + (size_t)m * D, g, dst + (size_t)m * D, F.lane);
}
__device__ __forceinline__ void p0_prologue(Frame& F) {
    LAS float* scr = (LAS float*)(F.lds + RING_OFF + F.wave * 16384);
    const int gw = F.vcu * NWAVES + F.wave, NGW = F.G * NWAVES;
    constexpr int I_GU = (D / 64) * (FF / 32), I_DN = (FF / 64) * (D / 32), I_IN = (D / 64) * (NIN / 32), I_OUT = (D / 64) * (D / 32);
    constexpr int NITEMS = 4 * I_GU + 2 * I_DN + I_IN + I_OUT;
    for (int it = gw; it < NITEMS; it += NGW) {
        int r = it;
        if (r < I_GU) { p0_transpose_item(F.wg1, D, FF, F.WGU1, 1, scr, r, F.lane); continue; } r -= I_GU;
        if (r < I_GU) { p0_transpose_item(F.wu1, D, FF, F.WGU1, 2, scr, r, F.lane); continue; } r -= I_GU;
        if (r < I_DN) { p0_transpose_item(F.wd1, FF, D, F.WD1, 0, scr, r, F.lane); continue; } r -= I_DN;
        if (r < I_IN) { p0_transpose_item(F.win, D, NIN, F.WIN, 0, scr, r, F.lane); continue; } r -= I_IN;
        if (r < I_OUT) { p0_transpose_item(F.wout, D, D, F.WOUT, 0, scr, r, F.lane); continue; } r -= I_OUT;
        if (r < I_GU) { p0_transpose_item(F.wg2, D, FF, F.WGU2, 1, scr, r, F.lane); continue; } r -= I_GU;
        if (r < I_GU) { p0_transpose_item(F.wu2, D, FF, F.WGU2, 2, scr, r, F.lane); continue; } r -= I_GU;
        p0_transpose_item(F.wd2, FF, D, F.WD2, 0, scr, r, F.lane);
    }
    norm_phase_bf16(F, F.x, F.n1, F.XN);
}

__device__ __forceinline__ void kmean_phase(Frame& F) {
    const int gw = F.vcu * NWAVES + F.wave, NGW = F.G * NWAVES, rg = F.lane >> 4, c8 = F.lane & 15;
    for (int item = gw; item < BATCH * 16 * NHEAD; item += NGW) {
        const int b = item >> 8, n = (item >> 4) & 15, h = item & 15;
        const bf16* base = F.MK + ((size_t)(b * SEQ + n * 256 + rg)) * HW + h * HD + 8 * c8;
        float s[8]; float mx = 0.f;
#pragma unroll
        for (int k = 0; k < 8; ++k) s[k] = 0.f;
#pragma unroll 8
        for (int i = 0; i < 64; ++i) { const v4u w = *(const GAS v4u*)(base + (size_t)(4 * i) * HW);
            const float e0 = bf_lo(w.x), e1 = bf_hi(w.x), e2 = bf_lo(w.y), e3 = bf_hi(w.y), e4 = bf_lo(w.z), e5 = bf_hi(w.z), e6 = bf_lo(w.w), e7 = bf_hi(w.w);
            s[0] += e0; s[1] += e1; s[2] += e2; s[3] += e3; s[4] += e4; s[5] += e5; s[6] += e6; s[7] += e7;
            float q = ((e0 * e0 + e1 * e1) + (e2 * e2 + e3 * e3)) + ((e4 * e4 + e5 * e5) + (e6 * e6 + e7 * e7));
            q += __shfl_xor(q, 1); q += __shfl_xor(q, 2); q += __shfl_xor(q, 4); q += __shfl_xor(q, 8);
            mx = fmaxf(mx, q); }
#pragma unroll
        for (int k = 0; k < 8; ++k) { s[k] += __shfl_xor(s[k], 16); s[k] += __shfl_xor(s[k], 32); s[k] *= (1.f / 256.f); }
        mx = fmaxf(mx, __shfl_xor(mx, 16)); mx = fmaxf(mx, __shfl_xor(mx, 32));
        if (F.lane < 16) { GAS f32x4* o = (GAS f32x4*)(F.KMEAN + ((size_t)((b * 16 + h) * 16 + n)) * HD + 8 * c8);
            o[0] = (f32x4){s[0], s[1], s[2], s[3]}; o[1] = (f32x4){s[4], s[5], s[6], s[7]}; }
        if (F.lane == 0) F.KMEAN[(size_t)BATCH * NHEAD * 16 * HD + (b * 16 + h) * 16 + n] = mx;
    }
}

namespace hg4 {
__device__ __forceinline__ unsigned pk2h(float lo, float hi) { unsigned r; asm("v_cvt_pk_bf16_f32 %0, %1, %2" : "=v"(r) : "v"(lo), "v"(hi)); return r; }
constexpr int PQ = 288, PKT = 160, PV = 160, PP = 160, PS = 288;
constexpr int Q_OFF = 0, K_OFF = Q_OFF + 64 * PQ, KT_OFF = K_OFF + 64 * PQ, V_OFF = KT_OFF + 128 * 128, P_OFF = V_OFF + 128 * PV, S_OFF = P_OFF + 64 * PP, SS_OFF = S_OFF + 128 * 256, TOT_OFF = P_OFF  , DA_OFF = SS_OFF + 512, GA_OFF = DA_OFF + 512, LDS_END = GA_OFF + 512;
static_assert(LDS_END <= RING_BYTES, "hgrn scan LDS");
#define HFRAG(base, pitch, row, q, ks) (*(const LAS bf16x8*)((base) + (row) * (pitch) + (q) * 16 + (ks) * 64))
#define HFRAG_KT(row, q, ks) (*(const LAS bf16x8*)(L + KT_OFF + (row) * 128 + ((((q) + 4 * (ks)) ^ (((row) >> 1) & 7)) << 4)))
#define HFRAG_S(row, q, ks) (*(const LAS bf16x8*)(L + S_OFF + (row) * 256 + ((((q) + 4 * (ks)) ^ ((row) & 15)) << 4)))
__device__ __forceinline__ void scan_unit(Frame& F, int bh) {
    int tid = threadIdx.x; asm volatile("" : "+v"(tid));
    const int w = __builtin_amdgcn_readfirstlane(tid >> 6), lane = tid & 63, lr = lane & 15, lq = lane >> 4;
    const int b = bh >> 4, h = bh & 15; const size_t row0 = (size_t)b * SEQ;
    LAS unsigned char* L = F.lds + RING_OFF;
    const int kq = tid & 31, sg = tid >> 5;
    const GAS f32x4* Fg = (const GAS f32x4*)(F.FG + (row0 + 4 * sg) * HW + h * HD + 4 * kq); const GAS v2u* Qg = (const GAS v2u*)(F.QH + (row0 + 4 * sg) * HW + h * HD + 4 * kq);
    const GAS v4u* Vg = (const GAS v4u*)(F.VH + (row0 + (tid & 63)) * HW + h * HD + 16 * (tid >> 6));
    const int tt = w & 3, sh = w >> 2;
    const GAS v2u* Gg = (const GAS v2u*)(F.GH + (row0 + 16 * tt + lr) * HW + h * HD + 64 * sh + 4 * lq);
    GAS v2u* Mg = (GAS v2u*)(F.XN + (row0 + 16 * tt + lr) * D + h * HD + 64 * sh + 4 * lq);
    if (tid < 32) *(LAS f32x4*)(L + GA_OFF + 16 * tid) = *(const GAS f32x4*)(F.hnorm + 4 * tid);
    f32x4 fX[4]; v2u qX[4]; v4u pv0, pv1;
#define H4_LOADFQ(FS, QS, c) do { _Pragma("unroll") for (int i_ = 0; i_ < 4; ++i_) { FS[i_] = Fg[(size_t)((c) * 64 + i_) * (HW / 4)]; QS[i_] = Qg[(size_t)((c) * 64 + i_) * (HW / 4)]; } } while (0)
#define H4_LOADV(c) do { pv0 = Vg[(size_t)(c) * 64 * (HW / 8)]; pv1 = Vg[(size_t)(c) * 64 * (HW / 8) + 1]; } while (0)
#define H4_PREP1(FS) do { f32x4 run_ = {0.f, 0.f, 0.f, 0.f}; \
        _Pragma("unroll") for (int i_ = 0; i_ < 4; ++i_) { run_[0] += __builtin_amdgcn_logf(FS[i_][0]); run_[1] += __builtin_amdgcn_logf(FS[i_][1]); run_[2] += __builtin_amdgcn_logf(FS[i_][2]); run_[3] += __builtin_amdgcn_logf(FS[i_][3]); } \
        *(LAS f32x4*)(L + TOT_OFF + sg * 512 + 16 * kq) = run_; } while (0)
#define H4_PREP2(FS, QS) do { f32x4 off_ = {0.f, 0.f, 0.f, 0.f}, tot_ = {0.f, 0.f, 0.f, 0.f}; \
        _Pragma("unroll") for (int s_ = 0; s_ < 16; ++s_) { const f32x4 t_ = *(const LAS f32x4*)(L + TOT_OFF + s_ * 512 + 16 * kq); tot_ = tot_ + t_; if (s_ < sg) off_ = off_ + t_; } \
        if (sg == 0) *(LAS f32x4*)(L + DA_OFF + 16 * kq) = (f32x4){__builtin_amdgcn_exp2f(tot_[0]), __builtin_amdgcn_exp2f(tot_[1]), __builtin_amdgcn_exp2f(tot_[2]), __builtin_amdgcn_exp2f(tot_[3])}; \
        float kv_[4][4]; \
        f32x4 c_ = off_;        \
        _Pragma("unroll") for (int i_ = 0; i_ < 4; ++i_) { c_[0] += __builtin_amdgcn_logf(FS[i_][0]); c_[1] += __builtin_amdgcn_logf(FS[i_][1]); c_[2] += __builtin_amdgcn_logf(FS[i_][2]); c_[3] += __builtin_amdgcn_logf(FS[i_][3]); \
            const float qv_[4] = {bf_lo(QS[i_].x), bf_hi(QS[i_].x), bf_lo(QS[i_].y), bf_hi(QS[i_].y)}; float qs_[4]; \
            _Pragma("unroll") for (int e_ = 0; e_ < 4; ++e_) { qs_[e_] = qv_[e_] * __builtin_amdgcn_exp2f(c_[e_]); kv_[i_][e_] = (1.f - FS[i_][e_]) * __builtin_amdgcn_exp2f(fminf(-c_[e_], 100.f)); } \
            *(LAS v2u*)(L + Q_OFF + (4 * sg + i_) * PQ + 8 * kq) = (v2u){pk2h(qs_[0], qs_[1]), pk2h(qs_[2], qs_[3])}; \
            *(LAS v2u*)(L + K_OFF + (4 * sg + i_) * PQ + 8 * kq) = (v2u){pk2h(kv_[i_][0], kv_[i_][1]), pk2h(kv_[i_][2], kv_[i_][3])}; } \
        _Pragma("unroll") for (int e_ = 0; e_ < 4; ++e_) { const int k_ = 4 * kq + e_; *(LAS v2u*)(L + KT_OFF + k_ * 128 + (((sg >> 1) ^ ((k_ >> 1) & 7)) << 4) + 8 * (sg & 1)) = (v2u){pk2h(kv_[0][e_], kv_[1][e_]), pk2h(kv_[2][e_], kv_[3][e_])}; } \
        { LAS unsigned short* vt_ = (LAS unsigned short*)(L + V_OFF + (16 * (tid >> 6)) * PV + (tid & 63) * 2); \
          vt_[0 * (PV / 2)] = (unsigned short)pv0.x; vt_[1 * (PV / 2)] = (unsigned short)(pv0.x >> 16); vt_[2 * (PV / 2)] = (unsigned short)pv0.y; vt_[3 * (PV / 2)] = (unsigned short)(pv0.y >> 16); \
          vt_[4 * (PV / 2)] = (unsigned short)pv0.z; vt_[5 * (PV / 2)] = (unsigned short)(pv0.z >> 16); vt_[6 * (PV / 2)] = (unsigned short)pv0.w; vt_[7 * (PV / 2)] = (unsigned short)(pv0.w >> 16); \
          vt_[8 * (PV / 2)] = (unsigned short)pv1.x; vt_[9 * (PV / 2)] = (unsigned short)(pv1.x >> 16); vt_[10 * (PV / 2)] = (unsigned short)pv1.y; vt_[11 * (PV / 2)] = (unsigned short)(pv1.y >> 16); \
          vt_[12 * (PV / 2)] = (unsigned short)pv1.z; vt_[13 * (PV / 2)] = (unsigned short)(pv1.z >> 16); vt_[14 * (PV / 2)] = (unsigned short)pv1.w; vt_[15 * (PV / 2)] = (unsigned short)(pv1.w >> 16); } } while (0)
    f32x4 st[8];
#pragma unroll
    for (int vt = 0; vt < 8; ++vt) st[vt] = (f32x4){0.f, 0.f, 0.f, 0.f};
    H4_LOADFQ(fX, qX, 0); H4_LOADV(0);
    for (int i = tid; i < 128 * 256 / 4; i += NWAVES * 64) ((LAS unsigned*)(L + S_OFF))[i] = 0u;
    H4_PREP1(fX); LDS_WAIT(); __syncthreads(); H4_PREP2(fX, qX); H4_LOADFQ(fX, qX, 1); LDS_WAIT(); __syncthreads();
#define H4_CHUNK(c, FN, QN) do { \
        if ((c) + 1 < SEQ / 64) H4_LOADV((c) + 1); \
          \
        { bf16x8 qf[4]; \
          _Pragma("unroll") for (int ks = 0; ks < 4; ++ks) qf[ks] = HFRAG(L + Q_OFF, PQ, 16 * tt + lr, lq, ks); \
          _Pragma("unroll") for (int i = 0; i < 2; ++i) { const int stile = 2 * sh + i; f32x4 a = {0.f, 0.f, 0.f, 0.f}; \
              if (stile <= tt) { \
                  _Pragma("unroll") for (int ks = 0; ks < 4; ++ks) a = __builtin_amdgcn_mfma_f32_16x16x32_bf16(HFRAG(L + K_OFF, PQ, 16 * stile + lr, lq, ks), qf[ks], a, 0, 0, 0); \
                  if (stile == tt) { _Pragma("unroll") for (int e = 0; e < 4; ++e) if (4 * lq + e > lr) a[e] = 0.f; } } \
              v2u pw; pw.x = pk2(a[0], a[1]); pw.y = pk2(a[2], a[3]); \
              *(LAS v2u*)(L + P_OFF + (16 * tt + lr) * PP + (16 * stile + 4 * lq) * 2) = pw; } } \
        { bf16x8 kf[2]; \
          _Pragma("unroll") for (int ks = 0; ks < 2; ++ks) kf[ks] = HFRAG_KT(16 * w + lr, lq, ks); \
          _Pragma("unroll") for (int vt = 0; vt < 8; ++vt) \
              _Pragma("unroll") for (int ks = 0; ks < 2; ++ks) st[vt] = __builtin_amdgcn_mfma_f32_16x16x32_bf16(kf[ks], HFRAG(L + V_OFF, PV, 16 * vt + lr, lq, ks), st[vt], 0, 0, 0); } \
        LDS_WAIT(); __syncthreads(); \
          \
        f32x4 o[4]; \
        { bf16x8 pf2[2], qf[4]; \
          _Pragma("unroll") for (int ks = 0; ks < 2; ++ks) pf2[ks] = HFRAG(L + P_OFF, PP, 16 * tt + lr, lq, ks); \
          _Pragma("unroll") for (int ks = 0; ks < 4; ++ks) qf[ks] = HFRAG(L + Q_OFF, PQ, 16 * tt + lr, lq, ks); \
          float ssq = 0.f; \
          _Pragma("unroll") for (int i = 0; i < 4; ++i) { const int vt = 4 * sh + i; f32x4 a = {0.f, 0.f, 0.f, 0.f}; \
              _Pragma("unroll") for (int ks = 0; ks < 2; ++ks) a = __builtin_amdgcn_mfma_f32_16x16x32_bf16(HFRAG(L + V_OFF, PV, 16 * vt + lr, lq, ks), pf2[ks], a, 0, 0, 0); \
              _Pragma("unroll") for (int ks = 0; ks < 4; ++ks) a = __builtin_amdgcn_mfma_f32_16x16x32_bf16(HFRAG_S(16 * vt + lr, lq, ks), qf[ks], a, 0, 0, 0); \
              o[i] = a; ssq += (a[0] * a[0] + a[1] * a[1]) + (a[2] * a[2] + a[3] * a[3]); } \
          ssq += __shfl_xor(ssq, 16); ssq += __shfl_xor(ssq, 32); \
          if (lq == 0) ((LAS float*)(L + SS_OFF))[sh * 64 + 16 * tt + lr] = ssq; } \
        LDS_WAIT(); __syncthreads(); \
          \
        v2u gt[4]; \
        _Pragma("unroll") for (int i = 0; i < 4; ++i) gt[i] = Gg[(size_t)((c) * 64) * (HW / 4) + 4 * i]; \
        { const f32x4 dcur = *(const LAS f32x4*)(L + DA_OFF + (16 * w + 4 * lq) * 4); LAS unsigned char* Sn = L + S_OFF + lr * 256 + (((2 * w + (lq >> 1)) ^ lr) << 4) + 8 * (lq & 1);       \
          _Pragma("unroll") for (int vt = 0; vt < 8; ++vt) { st[vt] = st[vt] * dcur; v2u s0; s0.x = pk2h(st[vt][0], st[vt][1]); s0.y = pk2h(st[vt][2], st[vt][3]); *(LAS v2u*)(Sn + vt * 16 * 256) = s0; } } \
        if ((c) + 1 < SEQ / 64) H4_PREP1(FN); \
        LDS_WAIT(); __syncthreads(); \
          \
        if ((c) + 1 < SEQ / 64) H4_PREP2(FN, QN); \
        if ((c) + 2 < SEQ / 64) H4_LOADFQ(FN, QN, (c) + 2); \
        LDS_WAIT(); __syncthreads(); \
          \
        { const float r = 1.f / sqrtf((((const LAS float*)(L + SS_OFF))[16 * tt + lr] + ((const LAS float*)(L + SS_OFF))[64 + 16 * tt + lr]) * (1.f / HD) + RMS_EPS); \
          _Pragma("unroll") for (int i = 0; i < 4; ++i) { const f32x4 gn = *(const LAS f32x4*)(L + GA_OFF + (64 * sh + 16 * i + 4 * lq) * 4); v2u wv; wv.x = pk2h((o[i][0] * r) * gn[0] * bf_lo(gt[i].x), (o[i][1] * r) * gn[1] * bf_hi(gt[i].x)); \
              wv.y = pk2h((o[i][2] * r) * gn[2] * bf_lo(gt[i].y), (o[i][3] * r) * gn[3] * bf_hi(gt[i].y)); \
              Mg[(size_t)((c) * 64) * (D / 4) + 4 * i] = wv; } } } while (0)
    for (int c = 0; c < SEQ / 64; ++c) { H4_CHUNK(c, fX, qX); }
    LDS_WAIT(); __syncthreads();
#undef H4_CHUNK
#undef H4_LOADFQ
#undef H4_LOADV
#undef H4_PREP1
#undef H4_PREP2
}
#undef HFRAG
#undef HFRAG_KT
#undef HFRAG_S
}


namespace moba {
#define KSWZ(row, colB) ((row) * 256 + ((colB) ^ (((row) & 7) << 4)))
#define SBAR() __builtin_amdgcn_sched_barrier(0)
constexpr int SHM_K = 16384, SHM_V = 16384;
constexpr int V_OFF = 0, K_OFF = 2 * SHM_V, WS_OFF = K_OFF + 2 * SHM_K, G_OFF = WS_OFF + NWAVES * 256, QM_OFF = G_OFF + 32 * 256, LDS_END = QM_OFF + 64;
static_assert(LDS_END <= RING_BYTES, "moba LDS");
__device__ __forceinline__ int v_st(int k, int c) { const int kk = (k & ~0xC) | ((k & 4) << 1) | ((k & 8) >> 1); return ((kk >> 3) * 4 + (c >> 5)) * 512 + ((kk & 7) * 32 + (c & 31)) * 2; }
__device__ __forceinline__ int v_rd_base(int lane) { return ((lane & 3) << 3) | (((lane >> 2) & 3) << 6) | (((lane >> 4) & 1) << 5) | (((lane >> 5) & 1) << 8); }
constexpr int v_rd_off(int d0, int ks, int half) { return d0 * 512 + ks * 4096 + half * 2048; }
__device__ __forceinline__ int crow(int r, int hi) { return (r & 3) + 8 * (r >> 2) + 4 * hi; }
__device__ __forceinline__ unsigned cvtpk(float lo, float hi) { unsigned r; asm volatile("v_cvt_pk_bf16_f32 %0, %1, %2" : "=v"(r) : "v"(lo), "v"(hi)); return r; }

template <int KB>
__device__ __forceinline__ void qkt(f32x16& p0, f32x16& p1, const LAS unsigned char* K_lds, int r32, int hi, const bf16x8* qr) {
    const LAS unsigned char* kb[4];
#pragma unroll
    for (int dd = 0; dd < 4; ++dd) kb[dd] = K_lds + KB * SHM_K + KSWZ(r32, (dd * 16 + hi * 8) * 2);
#pragma unroll
    for (int d0 = 0; d0 < 8; ++d0) { const LAS unsigned char* a = kb[d0 & 3] + (d0 >> 2) * 128;
        const bf16x8 b0 = *(const LAS bf16x8*)a;
        const bf16x8 b1 = *(const LAS bf16x8*)(a + 32 * 256);
        p0 = __builtin_amdgcn_mfma_f32_32x32x16_bf16(b0, qr[d0], p0, 0, 0, 0);
        p1 = __builtin_amdgcn_mfma_f32_32x32x16_bf16(b1, qr[d0], p1, 0, 0, 0);
        if (d0 & 1) SBAR(); }
}
template <int VB>
__device__ __forceinline__ void pv_tile(f32x16* o, int vb0, bf16x8 pa0, bf16x8 pa1, bf16x8 pa2, bf16x8 pa3) {
#define TRRD(dst, off) asm volatile("ds_read_b64_tr_b16 %0, %1 offset:%2" : "=&v"(dst) : "v"(vb0), "i"(off) : "memory")
#define PV_D0(d0) do { s16x4 l0, l1, l2, l3, h0, h1, h2, h3; constexpr int b_ = VB * SHM_V + v_rd_off(d0, 0, 0); \
        TRRD(l0, b_); TRRD(h0, b_ + 2048); TRRD(l1, b_ + 4096); TRRD(h1, b_ + 6144); TRRD(l2, b_ + 8192); TRRD(h2, b_ + 10240); TRRD(l3, b_ + 12288); TRRD(h3, b_ + 14336); \
        asm volatile("s_waitcnt lgkmcnt(0)" ::: "memory"); SBAR(); \
        o[d0] = __builtin_amdgcn_mfma_f32_32x32x16_bf16(pa0, (bf16x8){l0[0], l0[1], l0[2], l0[3], h0[0], h0[1], h0[2], h0[3]}, o[d0], 0, 0, 0);   \
        o[d0] = __builtin_amdgcn_mfma_f32_32x32x16_bf16(pa1, (bf16x8){l1[0], l1[1], l1[2], l1[3], h1[0], h1[1], h1[2], h1[3]}, o[d0], 0, 0, 0);   \
        o[d0] = __builtin_amdgcn_mfma_f32_32x32x16_bf16(pa2, (bf16x8){l2[0], l2[1], l2[2], l2[3], h2[0], h2[1], h2[2], h2[3]}, o[d0], 0, 0, 0);   \
        o[d0] = __builtin_amdgcn_mfma_f32_32x32x16_bf16(pa3, (bf16x8){l3[0], l3[1], l3[2], l3[3], h3[0], h3[1], h3[2], h3[3]}, o[d0], 0, 0, 0); } while (0)
    PV_D0(0); PV_D0(1); PV_D0(2); PV_D0(3);
#undef PV_D0
#undef TRRD
}

__device__ __forceinline__ void unit(LAS unsigned char* lds, const bf16* MQ, const bf16* MK, const bf16* MV, const float* KMEAN, bf16* MIX, int b, int h, int j) {
    int tid = threadIdx.x; asm volatile("" : "+v"(tid));
    const int wid = __builtin_amdgcn_readfirstlane(tid >> 6), lane = tid & 63, r32 = lane & 31, hi = lane >> 5;
    LAS unsigned char* V_lds = lds + V_OFF; LAS unsigned char* K_lds = lds + K_OFF; LAS unsigned char* G_lds = lds + G_OFF;
    LAS float* wsx = (LAS float*)(lds + WS_OFF) + wid * 64; LAS float* li_l = wsx; LAS float* al_l = wsx + 32;
    const int sr = tid >> 4, sc = (tid & 15) * 8, vst0 = v_st(sr, sc), vst1 = v_st(32 + sr, sc), kws = KSWZ(sr, sc * 2);
    const int vb0 = (int)(uintptr_t)V_lds + v_rd_base(lane);
    const size_t rowb = (size_t)b * SEQ;
    const bf16* Kh = MK + rowb * HW + h * HD + sc; const bf16* Vh = MV + rowb * HW + h * HD + sc;
    const float slope2 = 1.4426950408889634f * __builtin_amdgcn_exp2f(-0.5f * (float)(h + 1));
    const int NT = 4 * (j + 1);
    bf16x8 st_k0, st_k1, st_v0, st_v1;
#define TLOAD(t) do { const size_t r_ = (size_t)((t) * 64 + sr) * HW; st_k0 = *(const GAS bf16x8*)(Kh + r_); st_k1 = *(const GAS bf16x8*)(Kh + r_ + (size_t)32 * HW); \
                      st_v0 = *(const GAS bf16x8*)(Vh + r_); st_v1 = *(const GAS bf16x8*)(Vh + r_ + (size_t)32 * HW); } while (0)
#define TWRITE(bf) do { *(LAS bf16x8*)(K_lds + (bf) * SHM_K + kws) = st_k0; *(LAS bf16x8*)(K_lds + (bf) * SHM_K + kws + 32 * 256) = st_k1; \
                        *(LAS bf16x8*)(V_lds + (bf) * SHM_V + vst0) = st_v0; *(LAS bf16x8*)(V_lds + (bf) * SHM_V + vst1) = st_v1; } while (0)
    bf16x8 qr[8];
    { const bf16* qrow = MQ + (rowb + (size_t)(j * 256 + wid * 32 + r32)) * HW + h * HD + hi * 8;
#pragma unroll
      for (int d0 = 0; d0 < 8; ++d0) qr[d0] = *(const GAS bf16x8*)(qrow + d0 * 16); }
    { const int n = tid >> 5, d4 = (tid & 31) * 4; const f32x4 km = *(const GAS f32x4*)(KMEAN + ((size_t)((b * NHEAD + h) * 16 + n)) * HD + d4);
      const unsigned h0 = f2bf(km.x), h1 = f2bf(km.y), h2 = f2bf(km.z), h3 = f2bf(km.w);
      const float l0 = km.x - __builtin_bit_cast(float, h0 << 16), l1 = km.y - __builtin_bit_cast(float, h1 << 16), l2 = km.z - __builtin_bit_cast(float, h2 << 16), l3 = km.w - __builtin_bit_cast(float, h3 << 16);
      v2u whi, wlo; whi.x = h0 | (h1 << 16); whi.y = h2 | (h3 << 16); wlo.x = pk2(l0, l1); wlo.y = pk2(l2, l3);
      *(LAS v2u*)(G_lds + KSWZ(n, d4 * 2)) = whi; *(LAS v2u*)(G_lds + KSWZ(16 + n, d4 * 2)) = wlo; }
    { float qn = 0.f;
#pragma unroll
      for (int d0 = 0; d0 < 8; ++d0) { const v4u qw = *reinterpret_cast<const v4u*>(&qr[d0]);
          qn += (bf_lo(qw.x) * bf_lo(qw.x) + bf_hi(qw.x) * bf_hi(qw.x)) + (bf_lo(qw.y) * bf_lo(qw.y) + bf_hi(qw.y) * bf_hi(qw.y)) + (bf_lo(qw.z) * bf_lo(qw.z) + bf_hi(qw.z) * bf_hi(qw.z)) + (bf_lo(qw.w) * bf_lo(qw.w) + bf_hi(qw.w) * bf_hi(qw.w)); }
      qn += __shfl_xor(qn, 32);
#pragma unroll
      for (int o_ = 1; o_ < 32; o_ <<= 1) qn = fmaxf(qn, __shfl_xor(qn, o_));
      if (lane == 0) ((LAS float*)(lds + QM_OFF))[wid] = qn; }
    LDS_WAIT(); __syncthreads();
    int t_first = 0;
    { float qm2 = 0.f;
#pragma unroll
      for (int w_ = 0; w_ < NWAVES; ++w_) qm2 = fmaxf(qm2, ((const LAS float*)(lds + QM_OFF))[w_]);
      float km2 = ((lane & 15) <= j) ? KMEAN[(size_t)BATCH * NHEAD * 16 * HD + (b * NHEAD + h) * 16 + (lane & 15)] : 0.f;
#pragma unroll
      for (int o_ = 1; o_ < 16; o_ <<= 1) km2 = fmaxf(km2, __shfl_xor(km2, o_));
      const float Bq = sqrtf(qm2 * km2) * 1.0001f + 0.01f;
      const float dist = (170.f + 2.f * Bq) / slope2;
      float gf = floorf((dist - 1.f) * (1.f / 256.f)) + 1.f; gf = fminf(fmaxf(gf, 1.f), 16.f);
      const int nf = j - (int)gf; t_first = __builtin_amdgcn_readfirstlane(nf > 0 ? 4 * nf : 0); }
    TLOAD(t_first); VM_WAIT(); TWRITE(0); LDS_WAIT(); __syncthreads();
    unsigned sel = 0u;
    if (j > 0) {
        f32x16 gp = {};
#pragma unroll
        for (int d0 = 0; d0 < 8; ++d0) { const bf16x8 a = *(const LAS bf16x8*)(G_lds + KSWZ(r32, (d0 * 16 + hi * 8) * 2)); gp = __builtin_amdgcn_mfma_f32_32x32x16_bf16(a, qr[d0], gp, 0, 0, 0); }
        float gm[8], go[8]; int nm[8];
        const float NEG = -__builtin_inff(); const bool hi1 = (hi != 0);
#pragma unroll
        for (int r = 0; r < 8; ++r) { nm[r] = (r & 3) + 8 * (r >> 2) + 4 * hi;
            const float gv = gp[r] + gp[r + 8]; gm[r] = (nm[r] < j) ? gv : NEG; }
#pragma unroll
        for (int r = 0; r < 8; ++r) go[r] = __shfl_xor(gm[r], 32);
        unsigned mine = 0u;
#pragma unroll
        for (int r = 0; r < 8; ++r) { int rank = 0;
#pragma unroll
            for (int q = 0; q < 8; ++q) {
                if (q != r) rank += (gm[q] > gm[r] || (gm[q] == gm[r] && q < r)) ? 1 : 0;
                const bool lower = ((q >> 2) < (r >> 2)) || (((q >> 2) == (r >> 2)) && hi1);
                rank += (go[q] > gm[r] || (go[q] == gm[r] && lower)) ? 1 : 0; }
            if (nm[r] < j && rank < 3) mine |= 1u << nm[r]; }
        sel = mine | (unsigned)__shfl_xor((int)mine, 32);
    }
    const float sl1 = slope2, sl2 = 2.f * slope2, sl3 = 3.f * slope2, sl8 = 8.f * slope2, slh = slope2 * (float)(4 * hi);
    const int tq = wid * 32 + r32;
    float m_reg = -1e30f, l_reg = 0.f; f32x16 o[4] = {};
    f32x16 p0, p1; bf16x8 pa0, pa1, pa2, pa3;
    const float NEGI = -__builtin_inff();
#define RESC(a) do { if (__any((a) < 1.f)) { if (hi == 0) al_l[r32] = (a); asm volatile("s_waitcnt lgkmcnt(0)" ::: "memory");              \
                     _Pragma("unroll") for (int d_ = 0; d_ < 4; ++d_) _Pragma("unroll") for (int r = 0; r < 16; ++r) o[d_][r] *= al_l[crow(r, hi)]; } } while (0)
#define PK4(P, B_, OUT) do { unsigned a0 = cvtpk(P[B_+0], P[B_+1]), a1 = cvtpk(P[B_+2], P[B_+3]);                          \
        unsigned b0 = cvtpk(P[B_+4], P[B_+5]), b1 = cvtpk(P[B_+6], P[B_+7]);                                             \
        auto r0 = __builtin_amdgcn_permlane32_swap(a0, b0, false, false); auto r1 = __builtin_amdgcn_permlane32_swap(a1, b1, false, false); \
        v4u w = {r0[0], r1[0], r0[1], r1[1]}; OUT = *reinterpret_cast<bf16x8*>(&w); } while (0)
#define TILE_STEP(t, KB) do { const int n_ = (t) >> 2, tt_ = (t) & 3; \
        if ((t) + 1 < NT) TLOAD((t) + 1); \
        const bool own_ = (n_ == j); \
        const bool act_ = !(own_ && 64 * tt_ > wid * 32 + 31);             \
        if (act_) { \
            const float bi_ = slope2 * (float)(256 * (n_ - j) + 64 * tt_) + slh; \
            _Pragma("unroll") for (int k_ = 0; k_ < 8; ++k_) { const float bk_ = bi_ + sl8 * (float)k_; \
                if (k_ < 4) { p0[4 * k_] = bk_; p0[4 * k_ + 1] = bk_ + sl1; p0[4 * k_ + 2] = bk_ + sl2; p0[4 * k_ + 3] = bk_ + sl3; } \
                else { p1[4 * k_ - 16] = bk_; p1[4 * k_ - 15] = bk_ + sl1; p1[4 * k_ - 14] = bk_ + sl2; p1[4 * k_ - 13] = bk_ + sl3; } } \
            qkt<KB>(p0, p1, K_lds, r32, hi, qr); \
            if (own_) { const int dq_ = tq - 64 * tt_ - 4 * hi; \
                _Pragma("unroll") for (int r = 0; r < 16; ++r) { const int c_ = (r & 3) + 8 * (r >> 2); if (dq_ - c_ < 0) p0[r] = NEGI; if (dq_ - c_ - 32 < 0) p1[r] = NEGI; } } \
            else { const bool on_ = ((sel >> n_) & 1u) != 0u; \
                _Pragma("unroll") for (int r = 0; r < 16; ++r) { p0[r] = on_ ? p0[r] : NEGI; p1[r] = on_ ? p1[r] : NEGI; } } \
            float pmax_ = p0[0]; \
            _Pragma("unroll") for (int r = 1; r < 16; ++r) pmax_ = fmaxf(pmax_, p0[r]); \
            _Pragma("unroll") for (int r = 0; r < 16; ++r) pmax_ = fmaxf(pmax_, p1[r]); \
            { auto rr_ = __builtin_amdgcn_permlane32_swap(__float_as_uint(pmax_), __float_as_uint(pmax_), false, false); pmax_ = fmaxf(__uint_as_float(rr_[0]), __uint_as_float(rr_[1])); } \
            const float mn_ = fmaxf(m_reg, pmax_); const float alpha_ = __builtin_amdgcn_exp2f(m_reg - mn_); m_reg = mn_; \
            _Pragma("unroll") for (int r = 0; r < 16; ++r) { p0[r] = __builtin_amdgcn_exp2f(p0[r] - mn_); p1[r] = __builtin_amdgcn_exp2f(p1[r] - mn_); } \
            float ps_ = 0.f; \
            _Pragma("unroll") for (int r = 0; r < 16; ++r) ps_ += p0[r]; \
            _Pragma("unroll") for (int r = 0; r < 16; ++r) ps_ += p1[r]; \
            { auto rr_ = __builtin_amdgcn_permlane32_swap(__float_as_uint(ps_), __float_as_uint(ps_), false, false); ps_ = __uint_as_float(rr_[0]) + __uint_as_float(rr_[1]); } \
            l_reg = l_reg * alpha_ + ps_; \
            RESC(alpha_); \
            PK4(p0, 0, pa0); PK4(p0, 8, pa1); PK4(p1, 0, pa2); PK4(p1, 8, pa3); \
            pv_tile<KB>(o, vb0, pa0, pa1, pa2, pa3); \
        } \
        if ((t) + 1 < NT) { VM_WAIT(); TWRITE((KB) ^ 1); } \
        LDS_WAIT(); __syncthreads(); } while (0)
    for (int t = t_first; t < NT; t += 2) { TILE_STEP(t, 0); TILE_STEP(t + 1, 1); }
    if (hi == 0) li_l[r32] = l_reg; asm volatile("s_waitcnt lgkmcnt(0)" ::: "memory");
    float rli[16];
#pragma unroll
    for (int r = 0; r < 16; ++r) rli[r] = __builtin_amdgcn_rcpf(li_l[crow(r, hi)]);
    bf16* Ow = MIX + (rowb + (size_t)(j * 256 + wid * 32)) * D + HW + h * HD;
#pragma unroll
    for (int r = 0; r < 16; ++r) { const int orow = crow(r, hi);
#pragma unroll
        for (int d0 = 0; d0 < 4; ++d0) { const float v = o[d0][r] * rli[r]; const float vn = __shfl_xor(v, 1);
            if ((r32 & 1) == 0) *(GAS unsigned*)(Ow + (size_t)orow * D + d0 * 32 + r32) = cvtpk(v, vn); } }
    LDS_WAIT(); __syncthreads();
#undef TLOAD
#undef TWRITE
#undef RESC
#undef PK4
#undef TILE_STEP
}
#undef KSWZ
#undef SBAR
}
__device__ __forceinline__ void moba_phase(Frame& F) {
    volatile LAS unsigned* slot = F.MISC + 16;
    const int x = (int)(blockIdx.x & 7u); unsigned* ctr = (unsigned*)(F.ctl + CW_QCTR + 64 * x);
    unsigned nxt = 0u;
    if (F.tid == 0) { nxt = __hip_atomic_fetch_add(ctr, 1u, __ATOMIC_RELAXED, __HIP_MEMORY_SCOPE_AGENT); slot[0] = nxt; }
    __syncthreads();
    unsigned cur = __builtin_amdgcn_readfirstlane(slot[0]);
    while (cur < 128u) {
        __syncthreads();
        if (F.tid == 0) nxt = __hip_atomic_fetch_add(ctr, 1u, __ATOMIC_RELAXED, __HIP_MEMORY_SCOPE_AGENT);
        const int j = 15 - (int)(cur >> 3), bh = 8 * x + (int)(cur & 7u);
        moba::unit(F.lds + RING_OFF, F.MQ, F.MK, F.MV, F.KMEAN, F.XN, bh >> 4, bh & 15, j);
        if (F.tid == 0) slot[0] = nxt;
        __syncthreads();
        cur = __builtin_amdgcn_readfirstlane(slot[0]);
    }
}


struct Args { const float* in[15]; float* out; unsigned char* ws; int ph_lo, ph_hi, li, pad; };
__global__ void __launch_bounds__(NWAVES * 64, 2) mk_fwd(Args args) {
    extern __shared__ __attribute__((aligned(16))) unsigned char lds[];
    Frame F;
    F.lds = (LAS unsigned char*)lds;
    F.MISC = (volatile LAS unsigned*)(F.lds + MISC_OFF);
    F.tid = threadIdx.x; F.lane = F.tid & 63; F.wave = __builtin_amdgcn_readfirstlane(F.tid >> 6);
    F.G = gridDim.x; { const int bx = blockIdx.x; F.vcu = (F.G % 8 == 0) ? (bx % 8) * (F.G / 8) + bx / 8 : bx; }
#define GRID_BAR(seam) do { if (N_LAUNCHES == PER_PHASE) { if (F.tid == 0) __hip_atomic_store(F.ctl + CW_TMO, 0xBADBA0u | (unsigned)(seam), RLX_AGENT); } \
    else { xcd_barrier(bar); } } while (0)
    unsigned char* ws = args.ws;
    F.ctl = (gu32*)(ws + WS_CTL);
    F.x = args.in[0]; F.n1 = args.in[1]; F.wg1 = args.in[2]; F.wu1 = args.in[3]; F.wd1 = args.in[4]; F.nmix = args.in[5]; F.win = args.in[6]; F.lbnd = args.in[7];
    F.hnorm = args.in[8]; F.wout = args.in[9]; F.n2 = args.in[10]; F.wg2 = args.in[11]; F.wu2 = args.in[12]; F.wd2 = args.in[13]; F.nfin = args.in[14]; F.out = args.out;
    F.WGU1 = (bf16*)(ws + WS_WGU1); F.WD1 = (bf16*)(ws + WS_WD1); F.WIN = (bf16*)(ws + WS_WIN); F.WOUT = (bf16*)(ws + WS_WOUT); F.WGU2 = (bf16*)(ws + WS_WGU2); F.WD2 = (bf16*)(ws + WS_WD2);
    F.XN = (bf16*)(ws + WS_XN); F.ACT = (bf16*)(ws + WS_ACT); F.QH = (bf16*)(ws + WS_QH); F.VH = (bf16*)(ws + WS_VH); F.GH = (bf16*)(ws + WS_GH);
    F.MQ = (bf16*)(ws + WS_MQ); F.MK = (bf16*)(ws + WS_MK); F.MV = (bf16*)(ws + WS_MV);
    F.FG = (float*)(ws + WS_F); F.ORAW = (float*)(ws + WS_ORAW); F.KMEAN = (float*)(ws + WS_KMEAN); F.KT = (bf16*)(ws + WS_KT); F.KTT = (bf16*)(ws + WS_KTT); F.DD = (float*)(ws + WS_DD);
    for (int u = F.tid; u < (LDS_BYTES - LDSCTL_OFF) / 4; u += NWAVES * 64) ((LAS unsigned*)(F.lds + LDSCTL_OFF))[u] = 0u;
    __syncthreads();
    XcdBarrier bar; bar.bar = (unsigned*)(F.ctl + CW_BAR); bar.x = 0; bar.st = nullptr;
    if (N_LAUNCHES != PER_PHASE) bar = xcd_barrier_post((unsigned*)(F.ctl + CW_BAR), F.MISC + 8);

    const int lo = args.ph_lo, hi = args.ph_hi;
#define IN(k) (lo <= (k) && (k) < hi)
#define BOTH(k) (IN(k) && IN((k) + 1))

    if (IN(0)) { p0_prologue(F); if (BOTH(0)) GRID_BAR(0); }
    if (IN(1)) {
        pg8::Gemm g{F.XN, F.WGU1, M, NGU, D}; pg8::StaticOrder S; S.init(M, NGU, F.G, (int)blockIdx.x);
        pg8::EpiSwiGLU E{F.ACT, FF};
        pg8::gemm_phase<pg8::EpiSwiGLU, pg8::StaticOrder, true, true>(F.lds + RING_OFF, g, S, E);
        if (BOTH(1)) GRID_BAR(1);
    }
    if (IN(2)) {
        pg8::Gemm g{F.ACT, F.WD1, M, D, FF}; pg8::StaticOrder S; S.init(M, D, F.G, (int)blockIdx.x);
        pg8::EpiResF32 E{F.x, F.out, D, 0.5f};
        pg8::gemm_phase<pg8::EpiResF32, pg8::StaticOrder, true, true>(F.lds + RING_OFF, g, S, E);
        if (BOTH(2)) GRID_BAR(2);
    }
    if (IN(3)) { norm_phase_bf16(F, F.out, F.nmix, F.XN); if (BOTH(3)) GRID_BAR(3); }
    if (IN(4)) {
        pg8::Gemm g{F.XN, F.WIN, M, NIN, D}; pg8::StaticOrder S; S.init(M, NIN, F.G, (int)blockIdx.x);
        pg8::EpiInProj E{F.QH, F.VH, F.GH, F.MQ, F.MK, F.MV, F.FG, F.lbnd};
        pg8::gemm_phase<pg8::EpiInProj, pg8::StaticOrder, true, true>(F.lds + RING_OFF, g, S, E);
        if (BOTH(4)) GRID_BAR(4);
    }
    if (IN(5)) { kmean_phase(F); if (BOTH(5)) GRID_BAR(5); }
    if (IN(6)) { if (blockIdx.x < BATCH * NHEAD) hg4::scan_unit(F, (int)blockIdx.x); moba_phase(F); if (BOTH(6)) GRID_BAR(6); }
    if (IN(7)) {
        pg8::Gemm g{F.XN, F.WOUT, M, D, D}; pg8::StaticOrder S; S.init(M, D, F.G, (int)blockIdx.x);
        pg8::EpiResF32 E{F.out, F.out, D, 1.0f};
        pg8::gemm_phase<pg8::EpiResF32, pg8::StaticOrder, true, true>(F.lds + RING_OFF, g, S, E);
        if (BOTH(7)) GRID_BAR(7);
    }
    if (IN(8)) { norm_phase_bf16(F, F.out, F.n2, F.XN); if (BOTH(8)) GRID_BAR(8); }
    if (IN(9)) {
        pg8::Gemm g{F.XN, F.WGU2, M, NGU, D}; pg8::StaticOrder S; S.init(M, NGU, F.G, (int)blockIdx.x);
        pg8::EpiSwiGLU E{F.ACT, FF};
        pg8::gemm_phase<pg8::EpiSwiGLU, pg8::StaticOrder, true, true>(F.lds + RING_OFF, g, S, E);
        if (BOTH(9)) GRID_BAR(9);
    }
    if (IN(10)) {
        pg8::Gemm g{F.ACT, F.WD2, M, D, FF}; pg8::StaticOrder S; S.init(M, D, F.G, (int)blockIdx.x);
        pg8::EpiResF32 E{F.out, F.out, D, 0.5f};
        pg8::gemm_phase<pg8::EpiResF32, pg8::StaticOrder, true, true>(F.lds + RING_OFF, g, S, E);
        if (BOTH(10)) GRID_BAR(10);
    }
    if (IN(11)) {
        const int gw = F.vcu * NWAVES + F.wave, NGW = F.G * NWAVES;
        for (int m = gw; m < M; m += NGW) rms_row_f32(F.out + (size_t)m * D, F.nfin, F.out + (size_t)m * D, F.lane);
    }
#undef IN
#undef BOTH
}

extern "C" void kernel_launch(void* const* d_in, const int* in_sizes, int n_in, void* d_out, int out_size, void* d_ws, size_t ws_size, hipStream_t stream) {
    static int grid = 0;
    if (grid == 0) {
        if (n_in != 15 || in_sizes[0] != M * D || out_size != M * D || ws_size < WS_END) { fprintf(stderr, "kernel_launch: shape/workspace mismatch (n_in %d, in0 %d, out %d, ws %zu); nothing launched\n", n_in, n_in > 0 ? in_sizes[0] : -1, out_size, ws_size); grid = -1; return; }
        int dev = 0, cus = 0, per_cu = 0;
        if (hipGetDevice(&dev) != hipSuccess || hipDeviceGetAttribute(&cus, hipDeviceAttributeMultiprocessorCount, dev) != hipSuccess) { fprintf(stderr, "kernel_launch: device query failed\n"); grid = -1; return; }
        if (hipFuncSetAttribute((const void*)mk_fwd, hipFuncAttributeMaxDynamicSharedMemorySize, LDS_BYTES) != hipSuccess) { fprintf(stderr, "kernel_launch: hipFuncSetAttribute failed\n"); grid = -1; return; }
        if (hipOccupancyMaxActiveBlocksPerMultiprocessor(&per_cu, (const void*)mk_fwd, NWAVES * 64, LDS_BYTES) != hipSuccess || per_cu < 1)
            fprintf(stderr, "kernel_launch: note: occupancy query reports %d workgroups per CU\n", per_cu);
        (void)hipGetLastError();
        grid = cus;
    }
    if (grid < 0) return;
    if (hipMemsetAsync((char*)d_ws + WS_CTL, 0, CTL_ZERO_BYTES, stream) != hipSuccess) { fprintf(stderr, "kernel_launch: hipMemsetAsync failed\n"); return; }
    Args a{};
    for (int i = 0; i < 15; ++i) a.in[i] = (const float*)d_in[i];
    a.out = (float*)d_out; a.ws = (unsigned char*)d_ws;
    for (int li = 0; li < N_LAUNCHES; ++li) {
        a.ph_lo = (N_LAUNCHES == PER_PHASE) ? li : 0; a.ph_hi = (N_LAUNCHES == PER_PHASE) ? li + 1 : PER_PHASE; a.li = li;
        hipLaunchKernelGGL(mk_fwd, dim3(grid), dim3(NWAVES * 64), LDS_BYTES, stream, a);
        const hipError_t le = hipPeekAtLastError();
        if (le != hipSuccess) { fprintf(stderr, "kernel_launch: launch %d failed: %s\n", li, hipGetErrorName(le)); break; }
    }
}
```
